# Optimizing an MI355X kernel written in HIP

```python
import jax, jax.numpy as jnp
from jax import lax
import numpy as np

D_MODEL = 1024
BATCH = 4
SEQ = 8192
DEPTH = 1

N_HEADS = 8
HEAD_DIM = 64
ATTN_WIDTH = N_HEADS * HEAD_DIM
CONV_CH = D_MODEL - ATTN_WIDTH
IN_COLS = 2 * CONV_CH + 3 * ATTN_WIDTH
CONV_WIDTH = 31
ROT_DIM = HEAD_DIM // 4
ROPE_THETA = 500000.0
DILATED_PATTERNS = ((128, 1), (512, 4), (2048, 16))
N_EXPERTS = 32
TOP_K = 4
D_FF = D_MODEL
SWIGLU_LIMIT = 7.0
SWIGLU_ALPHA = 1.702
MOE_BLOCK = 128
NORM_EPS = 1e-6

kernel_name = "hybrid_conv_dilated_attn_moe_adaln"

F32 = jnp.float32


def rms_norm(x, g):
    xf = x.astype(F32)
    y = xf * lax.rsqrt(jnp.mean(xf * xf, axis=-1, keepdims=True) + NORM_EPS)
    return (y * g.astype(F32)).astype(x.dtype)


def modulate(h, shift, scale):
    return h * (1.0 + scale) + shift


def rotary_tables(positions):
    inv_freq = ROPE_THETA ** (-jnp.arange(0, ROT_DIM, 2, dtype=F32) / ROT_DIM)
    ang = positions.astype(F32)[..., None] * inv_freq
    return jnp.cos(ang)[:, :, None, :], jnp.sin(ang)[:, :, None, :]


def apply_partial_rotary(t, cos, sin):
    half = ROT_DIM // 2
    tf = t.astype(F32)
    x1, x2, rest = tf[..., :half], tf[..., half:ROT_DIM], tf[..., ROT_DIM:]
    rot = jnp.concatenate([x1 * cos - x2 * sin, x2 * cos + x1 * sin, rest], axis=-1)
    return rot.astype(t.dtype)


def conformer_conv(a, g, conv_w, conv_b, ln_g, ln_b):
    u = a * jax.nn.sigmoid(g)
    y = lax.conv_general_dilated(
        u, conv_w.astype(u.dtype), window_strides=(1,),
        padding=[(CONV_WIDTH - 1, 0)],
        dimension_numbers=("NWC", "WIO", "NWC"),
        feature_group_count=CONV_CH) + conv_b
    yf = y.astype(F32)
    mu = jnp.mean(yf, axis=-1, keepdims=True)
    var = jnp.mean(jnp.square(yf - mu), axis=-1, keepdims=True)
    yn = (yf - mu) * lax.rsqrt(var + NORM_EPS) * ln_g.astype(F32) + ln_b.astype(F32)
    return jax.nn.silu(yn).astype(a.dtype)


def dilated_window_attention(q, k, v, window, dilation):
    Bb, S, H, hd = q.shape
    blk = window // dilation
    chunk = blk * dilation
    Sp = -(-S // chunk) * chunk
    L = Sp // dilation
    nb = L // blk

    def to_sub(t):
        t = jnp.pad(t, ((0, 0), (0, Sp - S), (0, 0), (0, 0)))
        t = t.reshape(Bb, L, dilation, H, hd).transpose(0, 2, 3, 1, 4)
        return t.reshape(Bb, dilation, H, nb, blk, hd)

    def with_prev(t):
        prev = jnp.pad(t, ((0, 0), (0, 0), (0, 0), (1, 0), (0, 0), (0, 0)))[:, :, :, :-1]
        return jnp.concatenate([prev, t], axis=4)

    qs = to_sub(q)
    ks = with_prev(to_sub(k))
    vs = with_prev(to_sub(v))
    s = jnp.einsum("bdhnqe,bdhnke->bdhnqk", qs.astype(F32), ks.astype(F32)) * (HEAD_DIM ** -0.5)
    qi = jnp.arange(blk)[:, None]
    kj = jnp.arange(2 * blk)[None, :]
    dist = qi + blk - kj
    band = (dist >= 0) & (dist <= blk)
    valid = band[None] & ((jnp.arange(nb)[:, None, None] > 0) | (kj >= blk)[None])
    s = jnp.where(valid, s, -jnp.inf)
    m = jnp.max(s, axis=-1)
    p = jnp.exp(s - m[..., None])
    l = jnp.sum(p, axis=-1)
    o = jnp.einsum("bdhnqk,bdhnke->bdhnqe", p, vs.astype(F32)) / l[..., None]

    o = o.reshape(Bb, dilation, H, L, hd).transpose(0, 3, 1, 2, 4).reshape(Bb, Sp, H, hd)[:, :S]
    m = m.reshape(Bb, dilation, H, L).transpose(0, 3, 1, 2).reshape(Bb, Sp, H)[:, :S]
    l = l.reshape(Bb, dilation, H, L).transpose(0, 3, 1, 2).reshape(Bb, Sp, H)[:, :S]
    return o, m, l


def dilated_mixture_attention(q, k, v):
    res = [dilated_window_attention(q, k, v, w, d) for (w, d) in DILATED_PATTERNS]
    m_all = jnp.max(jnp.stack([r[1] for r in res], axis=0), axis=0)
    wts = [jnp.exp(r[1] - m_all) * r[2] for r in res]
    num = sum(w[..., None] * r[0] for w, r in zip(wts, res))
    den = sum(wts)
    return num / den[..., None]


def routed_ffn(h, w_router, b_router, w_gu, b_gu, w_down, b_down):
    Bb, S, D = h.shape
    T = Bb * S
    hf = h.reshape(T, D)
    logits = hf.astype(F32) @ w_router.astype(F32) + b_router.astype(F32)
    top_val, top_idx = lax.top_k(logits, TOP_K)
    gates = jax.nn.softmax(top_val, axis=-1)

    A = T * TOP_K
    e_flat = top_idx.reshape(A).astype(jnp.int32)
    tok_flat = jnp.repeat(jnp.arange(T, dtype=jnp.int32), TOP_K)
    g_flat = gates.reshape(A)
    e_sorted, order = lax.sort((e_flat, jnp.arange(A, dtype=jnp.int32)), num_keys=1, is_stable=True)
    counts = jnp.bincount(e_flat, length=N_EXPERTS).astype(jnp.int32)
    starts = jnp.cumsum(counts) - counts
    padded = (counts + MOE_BLOCK - 1) // MOE_BLOCK * MOE_BLOCK
    pends = jnp.cumsum(padded)
    pstarts = pends - padded
    dest = pstarts[e_sorted] + (jnp.arange(A, dtype=jnp.int32) - starts[e_sorted])
    n_blocks = -(-A // MOE_BLOCK) + N_EXPERTS
    rows = n_blocks * MOE_BLOCK
    tok_pad = jnp.full((rows,), T, jnp.int32).at[dest].set(tok_flat[order])
    gate_pad = jnp.zeros((rows,), h.dtype).at[dest].set(g_flat[order].astype(h.dtype))
    block_start = jnp.arange(n_blocks, dtype=jnp.int32) * MOE_BLOCK
    block_expert = jnp.minimum(jnp.searchsorted(pends, block_start, side="right"), N_EXPERTS - 1).astype(jnp.int32)
    h_ext = jnp.concatenate([hf, jnp.zeros((1, D), hf.dtype)], axis=0)

    def expert_block(args):
        tok, e = args
        xb = h_ext[tok]
        gu = xb @ w_gu[e] + b_gu[e]
        gate = jnp.minimum(gu[:, :D_FF], SWIGLU_LIMIT)
        up = jnp.clip(gu[:, D_FF:], -SWIGLU_LIMIT, SWIGLU_LIMIT)
        act = (up + 1.0) * (gate * jax.nn.sigmoid(SWIGLU_ALPHA * gate))
        return act @ w_down[e] + b_down[e]

    y = lax.map(expert_block, (tok_pad.reshape(n_blocks, MOE_BLOCK), block_expert))
    y = y.reshape(rows, D) * gate_pad[:, None]
    out = jnp.zeros((T + 1, D), y.dtype).at[tok_pad].add(y)[:T]
    return out.reshape(Bb, S, D).astype(h.dtype)


def setup_inputs(seed: int = 0) -> dict:
    key = jax.random.key(seed)
    ks = jax.random.split(key, 24)

    def nrm(k, shape, scale):
        return jax.random.normal(k, shape, F32) * scale

    x = nrm(ks[0], (BATCH, SEQ, D_MODEL), 1.0)
    c = nrm(ks[1], (BATCH, D_MODEL), 1.0)
    positions = (jax.random.randint(ks[2], (BATCH, 1), 0, 4096, dtype=jnp.int32)
                 + jnp.arange(SEQ, dtype=jnp.int32)[None, :])
    return {
        "x": x,
        "c": c,
        "positions": positions,
        "w_ada": nrm(ks[3], (DEPTH, D_MODEL, 6 * D_MODEL), 0.5 * D_MODEL ** -0.5),
        "b_ada": nrm(ks[4], (DEPTH, 6 * D_MODEL), 0.02),
        "g_mix": 1.0 + nrm(ks[5], (DEPTH, D_MODEL), 0.05),
        "w_in": nrm(ks[6], (DEPTH, D_MODEL, IN_COLS), D_MODEL ** -0.5),
        "conv_w": nrm(ks[7], (DEPTH, CONV_WIDTH, 1, CONV_CH), CONV_WIDTH ** -0.5),
        "conv_b": nrm(ks[8], (DEPTH, CONV_CH), 0.02),
        "conv_ln_g": 1.0 + nrm(ks[9], (DEPTH, CONV_CH), 0.05),
        "conv_ln_b": nrm(ks[10], (DEPTH, CONV_CH), 0.02),
        "w_out": nrm(ks[11], (DEPTH, D_MODEL, D_MODEL), D_MODEL ** -0.5),
        "g_ffn": 1.0 + nrm(ks[12], (DEPTH, D_MODEL), 0.05),
        "w_router": nrm(ks[13], (DEPTH, D_MODEL, N_EXPERTS), D_MODEL ** -0.5),
        "b_router": nrm(ks[14], (DEPTH, N_EXPERTS), 0.01),
        "w_gu": nrm(ks[15], (DEPTH, N_EXPERTS, D_MODEL, 2 * D_FF), D_MODEL ** -0.5),
        "b_gu": nrm(ks[16], (DEPTH, N_EXPERTS, 2 * D_FF), 0.02),
        "w_down": nrm(ks[17], (DEPTH, N_EXPERTS, D_FF, D_MODEL), D_FF ** -0.5),
        "b_down": nrm(ks[18], (DEPTH, N_EXPERTS, D_MODEL), 0.02),
        "g_final": 1.0 + nrm(ks[19], (D_MODEL,), 0.05),
    }


def reference(x, c, positions, w_ada, b_ada, g_mix, w_in, conv_w, conv_b, conv_ln_g, conv_ln_b,
              w_out, g_ffn, w_router, b_router, w_gu, b_gu, w_down, b_down, g_final):
    Bb, S, _ = x.shape
    cos, sin = rotary_tables(positions)
    c_act = jax.nn.silu(c)
    splits = [CONV_CH, 2 * CONV_CH, 2 * CONV_CH + ATTN_WIDTH, 2 * CONV_CH + 2 * ATTN_WIDTH]
    for l in range(DEPTH):
        mod = (c_act @ w_ada[l] + b_ada[l])[:, None, :]
        sh1, sc1, gt1, sh2, sc2, gt2 = jnp.split(mod, 6, axis=-1)

        h = modulate(rms_norm(x, g_mix[l]), sh1, sc1)
        proj = h @ w_in[l]
        a, g, q, k, v = jnp.split(proj, splits, axis=-1)
        conv_out = conformer_conv(a, g, conv_w[l], conv_b[l], conv_ln_g[l], conv_ln_b[l])
        q = apply_partial_rotary(q.reshape(Bb, S, N_HEADS, HEAD_DIM), cos, sin)
        k = apply_partial_rotary(k.reshape(Bb, S, N_HEADS, HEAD_DIM), cos, sin)
        v = v.reshape(Bb, S, N_HEADS, HEAD_DIM)
        attn_out = dilated_mixture_attention(q, k, v).reshape(Bb, S, ATTN_WIDTH).astype(x.dtype)
        mixed = jnp.concatenate([conv_out, attn_out], axis=-1) @ w_out[l]
        x = x + gt1 * mixed

        h2 = modulate(rms_norm(x, g_ffn[l]), sh2, sc2)
        x = x + gt2 * routed_ffn(h2, w_router[l], b_router[l], w_gu[l], b_gu[l], w_down[l], b_down[l])
    return rms_norm(x, g_final)
```

```cpp
#include <hip/hip_runtime.h>
#include <cstdio>
#include <cstdint>

#define LAS __attribute__((address_space(3)))
#define GAS __attribute__((address_space(1)))
typedef unsigned short bf16_t;
typedef short bf16x8 __attribute__((ext_vector_type(8)));
typedef short s16x4 __attribute__((ext_vector_type(4)));
typedef float f32x2 __attribute__((ext_vector_type(2)));
typedef float f32x4 __attribute__((ext_vector_type(4)));
typedef float f32x16 __attribute__((ext_vector_type(16)));
typedef unsigned u32x2 __attribute__((ext_vector_type(2)));
typedef unsigned u32x4 __attribute__((ext_vector_type(4)));
typedef GAS unsigned gu32;
typedef int v4i __attribute__((ext_vector_type(4)));
typedef int v8i __attribute__((ext_vector_type(8)));

#ifndef DUP4_PARTS
#define DUP4_PARTS 3
#endif
#ifndef P4_PARTS
#define P4_PARTS 3
#endif
#ifndef BG_IN_ATTN
#define BG_IN_ATTN 1
#endif
#ifndef FUSE_SPLIT
#define FUSE_SPLIT 1
#endif
#ifndef ROUTER_MFMA
#define ROUTER_MFMA 1
#endif
#ifndef N_LAUNCH_MODE
#define N_LAUNCH_MODE 0
#endif

constexpr int NB = 4, SEQ = 8192, T = NB * SEQ, D = 1024, NE = 32, INC = 2560, NH = 8;
constexpr int NPHASE = 10;
constexpr float NORM_EPS = 1e-6f;

constexpr size_t MiB = 1u << 20;
constexpr size_t WS_CTL = 0, CTL_ZERO_BYTES = 1 * MiB;
constexpr size_t WS_MOD = 1 * MiB;
constexpr size_t WS_ROPE = 2 * MiB;
constexpr size_t WS_TOKINFO = 4 * MiB;
constexpr size_t WS_TOKLIST = 6 * MiB;
constexpr size_t WS_WIN = 10 * MiB;
constexpr size_t WS_WOUT = 16 * MiB;
constexpr size_t WS_WDOWN = 32 * MiB;
constexpr size_t WS_WGU = 96 * MiB;
constexpr size_t WS_H = 224 * MiB;
constexpr size_t WS_PROJ = 288 * MiB;
constexpr size_t WS_U = 448 * MiB;
constexpr size_t WS_Q = 480 * MiB, WS_K = 512 * MiB, WS_V = 544 * MiB;
constexpr size_t WS_MIX = 576 * MiB;
constexpr size_t WS_ACT = 640 * MiB;
constexpr size_t WS_Y = 288 * MiB;
constexpr size_t WS_X1B = 448 * MiB;
constexpr size_t WS_END = 912 * MiB;
constexpr int MAX_RT = 544;

constexpr int CW_BAR = 4096;
constexpr int CW_GCNT = 16384;

constexpr int LDS_BYTES = 155648;
constexpr int L_ROWTAB = 131072;
constexpr int L_TILE_E = 148480;
constexpr int L_TSTART = 150784;
constexpr int L_CNT = 151040;
constexpr int L_MISC = 155392;

__device__ __forceinline__ unsigned f2bf(float f) { unsigned u = __builtin_bit_cast(unsigned, f); return (u + 0x7fffu + ((u >> 16) & 1u)) >> 16; }
__device__ __forceinline__ unsigned pk2(float lo, float hi) { return f2bf(lo) | (f2bf(hi) << 16); }
__device__ __forceinline__ unsigned cvt_pk_bf16(float lo, float hi) { unsigned r; asm("v_cvt_pk_bf16_f32 %0, %1, %2" : "=v"(r) : "v"(lo), "v"(hi)); return r; }
__device__ __forceinline__ unsigned pk4_fp8(float a, float b, float c, float d) { unsigned w = 0; w = __builtin_amdgcn_cvt_pk_fp8_f32(a, b, w, false); w = __builtin_amdgcn_cvt_pk_fp8_f32(c, d, w, true); return w; }
__device__ __forceinline__ float bf_lo(unsigned u) { return __builtin_bit_cast(float, u << 16); }
__device__ __forceinline__ float bf_hi(unsigned u) { return __builtin_bit_cast(float, u & 0xffff0000u); }
__device__ __forceinline__ float wave_sum(float v) {
    int x = __builtin_bit_cast(int, v);
    v += __builtin_bit_cast(float, __builtin_amdgcn_update_dpp(0, x, 0xB1, 0xF, 0xF, false)); x = __builtin_bit_cast(int, v);
    v += __builtin_bit_cast(float, __builtin_amdgcn_update_dpp(0, x, 0x4E, 0xF, 0xF, false)); x = __builtin_bit_cast(int, v);
    v += __builtin_bit_cast(float, __builtin_amdgcn_update_dpp(0, x, 0x141, 0xF, 0xF, false)); x = __builtin_bit_cast(int, v);
    v += __builtin_bit_cast(float, __builtin_amdgcn_update_dpp(0, x, 0x140, 0xF, 0xF, false)); x = __builtin_bit_cast(int, v);
    const float r0 = __builtin_bit_cast(float, __builtin_amdgcn_readlane(x, 0)), r1 = __builtin_bit_cast(float, __builtin_amdgcn_readlane(x, 16));
    const float r2 = __builtin_bit_cast(float, __builtin_amdgcn_readlane(x, 32)), r3 = __builtin_bit_cast(float, __builtin_amdgcn_readlane(x, 48));
    return (r0 + r1) + (r2 + r3);
}
__device__ __forceinline__ float wave_max(float v) {
#pragma unroll
    for (int o = 1; o < 64; o <<= 1) v = fmaxf(v, __shfl_xor(v, o));
    return v;
}
__device__ __forceinline__ float fast_sigmoid(float x) { return __builtin_amdgcn_rcpf(1.0f + __builtin_amdgcn_exp2f(-1.4426950408889634f * x)); }

namespace pg8 {
constexpr int BM = 256, BK = 64, HALF = 128, HTB = HALF * BK * 2, STAGE_BYTES = 8 * HTB, NXCD = 8, WGM = 8;
constexpr int KD = 1024;

__host__ __device__ __forceinline__ int lds_byte(int r, int c) { const int st = (r >> 4) * 2 + (c >> 5), rr = r & 15, cc = c & 31, ob = rr * 64 + cc * 2; return st * 1024 + (ob ^ (((ob >> 9) & 1) << 5)); }
__host__ __device__ __forceinline__ void stage_rc(int b, int& R, int& C) { const int st = b / 1024, sb = b % 1024, swz = sb ^ (((sb >> 9) & 1) << 5); R = (st >> 1) * 16 + swz / 64; C = (st & 1) * 32 + (swz % 64) / 2; }
__host__ __device__ __forceinline__ int perm32(int rho) { const int n = rho >> 4, i = rho & 15; return 8 * (i >> 2) + 4 * n + (i & 3); }

struct Unit { int pm, pn, e, slot; };

template <class Epi, class Sched, bool ALIGN_EPI>
__device__ __forceinline__ void gemm_phase(LAS unsigned char* lds, const Sched& S, const Epi& E) {
    int tid_ = threadIdx.x; asm volatile("" : "+v"(tid_));
    const int tid = tid_, wid = __builtin_amdgcn_readfirstlane(tid >> 6), lane = tid & 63, wr = wid >> 2, wc = wid & 3, fr = lane & 15, fq = lane >> 4;
    constexpr bool FP8 = Sched::FP8; constexpr int PITCH = FP8 ? KD : KD * 2, nt = PITCH / 128;
    unsigned voffB[2];
#pragma unroll
    for (int i = 0; i < 2; ++i) { int R, C; stage_rc(tid * 16 + i * 8192, R, C); const int Rb = Epi::PERM ? ((R & ~31) + perm32(R & 31)) : R;
        voffB[i] = (unsigned)(Rb * PITCH + C * 2); }
#define PG8_AVOFF(U, V) do { int tid2_ = threadIdx.x; asm volatile("" : "+v"(tid2_)); int Rr[2], Cc[2]; _Pragma("unroll") for (int i = 0; i < 2; ++i) { int R, C; stage_rc(tid2_ * 16 + i * 8192, R, C); Rr[i] = R; Cc[i] = C * 2; } S.a_voff(U, Rr, Cc, V); } while (0)
    constexpr size_t kstep = (size_t)(BK * 2);
    constexpr size_t hstep = (size_t)HALF * PITCH;
    const unsigned ldsw = (unsigned)wid * 1024u;
    const int aoff = lds_byte(wr * 64 + fr, fq * 8), boff = lds_byte(wc * 32 + fr, fq * 8);
#define PG8_SA(b, h) (((b) * 2 + (h)) * HTB)
#define PG8_SB(b, h) ((4 + (b) * 2 + (h)) * HTB)
#define PG8_STAGE(bufoff, gbase, voff) do { _Pragma("unroll") for (int _i = 0; _i < 2; ++_i) \
        __builtin_amdgcn_global_load_lds((const unsigned*)((const char*)(gbase) + (voff)[_i]), (LAS unsigned*)(lds + (bufoff) + ldsw + _i * 8192), 16, 0, 0); } while (0)
#define PG8_LDA(dst, b, h) do { if constexpr (FP8) { _Pragma("unroll") for (int m = 0; m < 4; ++m) { const v4i lo_ = *(const LAS v4i*)(lds + PG8_SA(b, h) + aoff + m * 2048), hi_ = *(const LAS v4i*)(lds + PG8_SA(b, h) + aoff + m * 2048 + 1024); \
            dst##8[m] = __builtin_shufflevector(lo_, hi_, 0, 1, 2, 3, 4, 5, 6, 7); } } \
        else { _Pragma("unroll") for (int m = 0; m < 4; ++m) _Pragma("unroll") for (int k = 0; k < 2; ++k) dst[m][k] = *(const LAS bf16x8*)(lds + PG8_SA(b, h) + aoff + m * 2048 + k * 1024); } } while (0)
#define PG8_LDB(dst, b, h) do { if constexpr (FP8) { _Pragma("unroll") for (int n = 0; n < 2; ++n) { const v4i lo_ = *(const LAS v4i*)(lds + PG8_SB(b, h) + boff + n * 2048), hi_ = *(const LAS v4i*)(lds + PG8_SB(b, h) + boff + n * 2048 + 1024); \
            dst##8[n] = __builtin_shufflevector(lo_, hi_, 0, 1, 2, 3, 4, 5, 6, 7); } } \
        else { _Pragma("unroll") for (int n = 0; n < 2; ++n) _Pragma("unroll") for (int k = 0; k < 2; ++k) dst[n][k] = *(const LAS bf16x8*)(lds + PG8_SB(b, h) + boff + n * 2048 + k * 1024); } } while (0)
#define PG8_MMA(ai, bj, At, Bt) do { __builtin_amdgcn_s_setprio(1); _Pragma("unroll") for (int m = 0; m < 4; ++m) _Pragma("unroll") for (int n = 0; n < 2; ++n) { \
        if constexpr (FP8) asm volatile("v_mfma_scale_f32_16x16x128_f8f6f4 %0, %1, %2, %0, %3, %4 op_sel_hi:[0,0,0]" : "+v"(acc[ai][bj][m][n]) : "v"(Bt##8[n]), "v"(At##8[m]), "v"((bj) ? sc_w1 : sc_w), "v"(sc_a)); \
        else { _Pragma("unroll") for (int k = 0; k < 2; ++k) acc[ai][bj][m][n] = __builtin_amdgcn_mfma_f32_16x16x32_bf16(Bt[n][k], At[m][k], acc[ai][bj][m][n], 0, 0, 0); } } \
        __builtin_amdgcn_s_setprio(0); } while (0)
#define PG8_WAIT_V(n) asm volatile("s_waitcnt vmcnt(" #n ")" ::: "memory")
#define PG8_WAIT_L(n) asm volatile("s_waitcnt lgkmcnt(" #n ")" ::: "memory")
#define PG8_BAR __builtin_amdgcn_s_barrier()
#define PG8_SCHED __builtin_amdgcn_sched_barrier(0)
    Unit cur, nxt; int ui = 0;
    if (!S.next(0, cur)) return;
    f32x4 acc[2][2][4][2];
    typename Epi::Pre pre_n;
    { typename Epi::Pre pre_c; E.fetch_sync(pre_c, cur, wr, wc, fr, fq); E.init(acc, pre_c); }
    const int sc_w = Sched::SCALE_W, sc_w1 = Sched::SCALE_W1, sc_a = Sched::SCALE_A;
    bf16x8 At[4][2], B0[2][2], B1[2][2]; v8i At8[4], B08[2], B18[2];
    unsigned cAv[2][2], nAv[2][2];
    PG8_AVOFF(cur, cAv);
    const char* const Abase = S.a_base();
    const char* cB = S.b_tile(cur);
    PG8_STAGE(PG8_SB(0, 0), cB, voffB); PG8_STAGE(PG8_SB(0, 1), cB + hstep, voffB); PG8_STAGE(PG8_SA(0, 0), Abase, cAv[0]); PG8_STAGE(PG8_SA(0, 1), Abase, cAv[1]);
    if (wr == 1) PG8_BAR;
    PG8_WAIT_V(2); PG8_BAR;
    PG8_STAGE(PG8_SB(1, 0), cB + kstep, voffB); PG8_STAGE(PG8_SA(1, 0), Abase + kstep, cAv[0]); PG8_STAGE(PG8_SB(1, 1), cB + hstep + kstep, voffB);
    PG8_WAIT_V(6); PG8_BAR;
    for (;;) {
        const bool has_next = S.next(ui + 1, nxt);
        unsigned rAv[2][2];
        if (has_next) PG8_AVOFF(nxt, rAv); else { rAv[0][0] = cAv[0][0]; rAv[0][1] = cAv[0][1]; rAv[1][0] = cAv[1][0]; rAv[1][1] = cAv[1][1]; }
        const char* rB = has_next ? S.b_tile(nxt) : cB;
#ifdef DUP_K
#pragma unroll 1
      for (int rep_ = 0; rep_ < 2; ++rep_) {
        const char* nB = rep_ ? rB : cB;
        nAv[0][0] = rep_ ? rAv[0][0] : cAv[0][0]; nAv[0][1] = rep_ ? rAv[0][1] : cAv[0][1]; nAv[1][0] = rep_ ? rAv[1][0] : cAv[1][0]; nAv[1][1] = rep_ ? rAv[1][1] : cAv[1][1];
        if (rep_) { _Pragma("unroll") for (int a_ = 0; a_ < 2; ++a_) _Pragma("unroll") for (int b_ = 0; b_ < 2; ++b_) _Pragma("unroll") for (int m_ = 0; m_ < 4; ++m_) _Pragma("unroll") for (int n_ = 0; n_ < 2; ++n_) asm volatile("" :: "v"(acc[a_][b_][m_][n_]));
            typename Epi::Pre pre_r; E.fetch_sync(pre_r, cur, wr, wc, fr, fq); E.init(acc, pre_r); }
#else
        { const char* nB = rB; nAv[0][0] = rAv[0][0]; nAv[0][1] = rAv[0][1]; nAv[1][0] = rAv[1][0]; nAv[1][1] = rAv[1][1];
#endif
#pragma unroll 1
        for (int t = 0; t < nt; t += 2) {
            const bool last = (t == nt - 2);
            const char* a1 = Abase + (size_t)(t + 1) * kstep;
            const char* a2 = last ? Abase : Abase + (size_t)(t + 2) * kstep; const char* b2 = last ? nB : cB + (size_t)(t + 2) * kstep;
            const char* a3 = a2 + kstep; const char* b3 = b2 + kstep;
            unsigned a2v0[2], a2v1[2];
            a2v0[0] = last ? nAv[0][0] : cAv[0][0]; a2v0[1] = last ? nAv[0][1] : cAv[0][1];
            a2v1[0] = last ? nAv[1][0] : cAv[1][0]; a2v1[1] = last ? nAv[1][1] : cAv[1][1];
            PG8_LDB(B0, 0, 0); PG8_LDB(B1, 0, 1); PG8_SCHED; PG8_LDA(At, 0, 0); PG8_STAGE(PG8_SA(1, 1), a1, cAv[1]);
            PG8_WAIT_V(8); PG8_WAIT_L(0); PG8_BAR; PG8_MMA(0, 0, At, B0); PG8_MMA(0, 1, At, B1); PG8_BAR; PG8_SCHED;
            PG8_LDA(At, 0, 1); PG8_STAGE(PG8_SB(0, 0), b2, voffB); PG8_STAGE(PG8_SB(0, 1), b2 + hstep, voffB); PG8_STAGE(PG8_SA(0, 0), a2, a2v0);
            PG8_WAIT_V(8); PG8_WAIT_L(0); PG8_BAR; PG8_MMA(1, 0, At, B0); PG8_MMA(1, 1, At, B1); PG8_BAR; PG8_SCHED;
            PG8_LDB(B0, 1, 0); PG8_LDB(B1, 1, 1); PG8_SCHED; PG8_LDA(At, 1, 0); PG8_STAGE(PG8_SA(0, 1), a2, a2v1);
            PG8_WAIT_V(8); PG8_WAIT_L(0); PG8_BAR; PG8_MMA(0, 0, At, B0); PG8_MMA(0, 1, At, B1); PG8_BAR; PG8_SCHED;
            PG8_LDA(At, 1, 1); PG8_STAGE(PG8_SB(1, 0), b3, voffB); PG8_STAGE(PG8_SB(1, 1), b3 + hstep, voffB); PG8_STAGE(PG8_SA(1, 0), a3, a2v0);
            PG8_WAIT_V(8); PG8_WAIT_L(0); PG8_BAR; PG8_MMA(1, 0, At, B0); PG8_MMA(1, 1, At, B1); PG8_BAR; PG8_SCHED;
        }
      }
        const char* nB = rB;
        if constexpr (ALIGN_EPI) { if (wr == 0) PG8_BAR; }
        if constexpr (FP8) asm volatile("s_nop 15\n\ts_nop 15\n\ts_nop 15" ::: "memory");
        E(acc, cur, wr, wc, fr, fq);
#ifdef DUP_EPI
        if constexpr (FP8) { asm volatile("" ::: "memory"); E(acc, cur, wr, wc, fr, fq); }
#endif
        if (!has_next) break;
        E.fetch_sync(pre_n, nxt, wr, wc, fr, fq); E.init(acc, pre_n);
        cur = nxt; cB = nB; ++ui;
        cAv[0][0] = nAv[0][0]; cAv[0][1] = nAv[0][1]; cAv[1][0] = nAv[1][0]; cAv[1][1] = nAv[1][1];
        if constexpr (ALIGN_EPI) { if (wr == 1) PG8_BAR; }
    }
    PG8_WAIT_V(0);
    if constexpr (!ALIGN_EPI) { if (wr == 0) PG8_BAR; }
    PG8_BAR;
#undef PG8_AVOFF
#undef PG8_SA
#undef PG8_SB
#undef PG8_STAGE
#undef PG8_LDA
#undef PG8_LDB
#undef PG8_MMA
#undef PG8_WAIT_V
#undef PG8_WAIT_L
#undef PG8_BAR
#undef PG8_SCHED
}

__device__ __forceinline__ int xcd_remap(int wgid, int nwg) { const int q = nwg / NXCD, r = nwg % NXCD, xcd = wgid % NXCD, off = wgid / NXCD; return (xcd < r ? xcd * (q + 1) : r * (q + 1) + (xcd - r) * q) + off; }

struct PlainSched {
    static constexpr bool FP8 = false; static constexpr int SCALE_W = 0, SCALE_W1 = 0, SCALE_A = 0;
    int nM, nN, nwg, G, c; const char* A; const char* Bt;
    __device__ __forceinline__ void init(int M, int N, int G_, int c_, const void* A_, const void* Bt_) { nM = M / BM; nN = N / BM; nwg = nM * nN; G = G_; c = c_; A = (const char*)A_; Bt = (const char*)Bt_; }
    __device__ __forceinline__ bool next(int i, Unit& u) const {
        const long L = (long)i * G + c; if (L >= nwg) return false;
        const int wgid = xcd_remap((int)L, nwg);
        const int nig = WGM * nN, gid = wgid / nig, fm = gid * WGM, gsz = (nM - fm) < WGM ? (nM - fm) : WGM;
        u.pm = fm + ((wgid % nig) % gsz); u.pn = (wgid % nig) / gsz; u.e = 0; u.slot = i; return true;
    }
    __device__ __forceinline__ const char* a_base() const { return A; }
    __device__ __forceinline__ const char* b_tile(const Unit& u) const { return Bt + (size_t)u.pn * BM * KD * 2; }
    __device__ __forceinline__ void a_voff(const Unit& u, const int (&Rr)[2], const int (&Cc)[2], unsigned (&v)[2][2]) const {
#pragma unroll
        for (int h = 0; h < 2; ++h)
#pragma unroll
            for (int i = 0; i < 2; ++i) v[h][i] = (unsigned)((u.pm * BM + h * HALF + Rr[i]) * (KD * 2) + Cc[i]);
    }
};

template <bool GATHER>
struct MoeSched {
    static constexpr bool FP8 = true; static constexpr int SCALE_W = 0x79797979  , SCALE_A = GATHER ? 0x7B7B7B7B   : 0x7D7D7D7D  ;
    static constexpr int SCALE_W1 = GATHER ? 0x7B7B7B7B   : SCALE_W;
    int nN, nunits, G, c; const char* A; const char* Bt; size_t estride;
    const LAS int* tile_e; const LAS unsigned* rowtab;
    __device__ __forceinline__ bool next(int i, Unit& u) const {
        const long L = (long)i * G + c; if (L >= nunits) return false;
        const int id = xcd_remap((int)L, nunits);
        u.pm = id / nN; u.pn = id % nN; u.e = tile_e[u.pm]; u.slot = i; return true;
    }
    __device__ __forceinline__ const char* a_base() const { return A; }
    __device__ __forceinline__ const char* b_tile(const Unit& u) const { return Bt + (size_t)u.e * estride + (size_t)u.pn * BM * KD; }
    __device__ __forceinline__ void a_voff(const Unit& u, const int (&Rr)[2], const int (&Cc)[2], unsigned (&v)[2][2]) const {
#pragma unroll
        for (int h = 0; h < 2; ++h)
#pragma unroll
            for (int i = 0; i < 2; ++i) {
                if (GATHER) v[h][i] = rowtab[u.slot * 256 + h * HALF + Rr[i]] + (unsigned)Cc[i];
                else v[h][i] = (unsigned)((u.pm * BM + h * HALF + Rr[i]) * KD + Cc[i]);
            }
    }
};

__device__ __forceinline__ void load16_untracked(f32x4& dst, const float* p) { asm volatile("global_load_dwordx4 %0, %1, off" : "=v"(dst) : "v"(p) : "memory"); }
__device__ __forceinline__ void acc_zero(f32x4 (&acc)[2][2][4][2]) {
#pragma unroll
    for (int a = 0; a < 2; ++a)
#pragma unroll
        for (int b = 0; b < 2; ++b)
#pragma unroll
            for (int m = 0; m < 4; ++m)
#pragma unroll
                for (int n = 0; n < 2; ++n) acc[a][b][m][n] = (f32x4){0.f, 0.f, 0.f, 0.f};
}
struct EpiProj {
    static constexpr bool PERM = true;
    bf16_t* O;
    struct Pre { int none; };
    __device__ __forceinline__ void fetch_sync(Pre&, const Unit&, int, int, int, int) const {}
    __device__ __forceinline__ void fetch_async(Pre&, const Unit&, int, int, int, int) const {}
    __device__ __forceinline__ void init(f32x4 (&acc)[2][2][4][2], const Pre&) const { acc_zero(acc); }
    __device__ __forceinline__ void operator()(const f32x4 (&acc)[2][2][4][2], const Unit& u, int wr, int wc, int fr, int fq) const {
        const int row0 = u.pm * BM + wr * 64 + fr, col0 = u.pn * BM + wc * 32 + 8 * fq;
#pragma unroll
        for (int ai = 0; ai < 2; ++ai)
#pragma unroll
            for (int m = 0; m < 4; ++m) { bf16_t* rowp = O + (size_t)(row0 + ai * HALF + m * 16) * INC + col0;
#pragma unroll
                for (int bj = 0; bj < 2; ++bj) { const f32x4 v0 = acc[ai][bj][m][0], v1 = acc[ai][bj][m][1];
                    u32x4 w; w.x = cvt_pk_bf16(v0[0], v0[1]); w.y = cvt_pk_bf16(v0[2], v0[3]); w.z = cvt_pk_bf16(v1[0], v1[1]); w.w = cvt_pk_bf16(v1[2], v1[3]);
                    *(u32x4*)(rowp + bj * HALF) = w; } }
    }
};
struct EpiIn {
    static constexpr bool PERM = true;
    bf16_t* U; bf16_t* QKV; const float* rope;
    struct Pre { int none; };
    __device__ __forceinline__ void fetch_sync(Pre&, const Unit&, int, int, int, int) const {}
    __device__ __forceinline__ void fetch_async(Pre&, const Unit&, int, int, int, int) const {}
    __device__ __forceinline__ void init(f32x4 (&acc)[2][2][4][2], const Pre&) const { acc_zero(acc); }
    __device__ __forceinline__ void operator()(const f32x4 (&acc)[2][2][4][2], const Unit& u, int wr, int wc, int fr, int fq) const {
        const int row0 = u.pm * BM + wr * 64 + fr;
        if (u.pn < 4) {
            const int col0 = u.pn * HALF + wc * 32 + 8 * fq;
#pragma unroll
            for (int ai = 0; ai < 2; ++ai)
#pragma unroll
                for (int m = 0; m < 4; ++m) { const size_t row = (size_t)(row0 + ai * HALF + m * 16);
                    float o[8];
#pragma unroll
                    for (int n = 0; n < 2; ++n)
#pragma unroll
                        for (int j = 0; j < 4; ++j) o[4 * n + j] = acc[ai][0][m][n][j] * fast_sigmoid(acc[ai][1][m][n][j]);
                    u32x4 w; w.x = cvt_pk_bf16(o[0], o[1]); w.y = cvt_pk_bf16(o[2], o[3]); w.z = cvt_pk_bf16(o[4], o[5]); w.w = cvt_pk_bf16(o[6], o[7]);
                    *(u32x4*)(U + row * 512 + col0) = w; }
        } else {
            const int t = u.pn - 4;
            bf16_t* O = QKV + (size_t)(t >> 1) * ((WS_K - WS_Q) / 2);
            const int d0 = (wc & 1) * 32 + 8 * fq, hd0 = (t & 1) * 4 + (wc >> 1);
            const bool rot = (t < 4) && ((wc & 1) == 0) && (fq < 2);
            const int bb = (u.pm * BM) / SEQ, tok0 = (u.pm * BM) % SEQ + wr * 64 + fr;
            f32x4 cs[2][4], sn[2][4];
#pragma unroll
            for (int ai = 0; ai < 2; ++ai)
#pragma unroll
                for (int m = 0; m < 4; ++m) { cs[ai][m] = (f32x4){1.f, 1.f, 1.f, 1.f}; sn[ai][m] = (f32x4){0.f, 0.f, 0.f, 0.f}; }
            if (t < 4) { if (rot) {
#pragma unroll
                for (int ai = 0; ai < 2; ++ai)
#pragma unroll
                    for (int m = 0; m < 4; ++m) { const size_t row = (size_t)(row0 + ai * HALF + m * 16); cs[ai][m] = *(const f32x4*)(rope + row * 16 + 4 * fq); sn[ai][m] = *(const f32x4*)(rope + row * 16 + 8 + 4 * fq); } } }
            asm volatile("" ::: "memory");
#pragma unroll
            for (int ai = 0; ai < 2; ++ai)
#pragma unroll
                for (int m = 0; m < 4; ++m) { const int tok = tok0 + ai * HALF + m * 16;
#pragma unroll
                    for (int bj = 0; bj < 2; ++bj) { const f32x4 x1 = acc[ai][bj][m][0], x2 = acc[ai][bj][m][1];
                        const f32x4 v0 = x1 * cs[ai][m] - x2 * sn[ai][m], v1 = x2 * cs[ai][m] + x1 * sn[ai][m];
                        u32x4 w; w.x = cvt_pk_bf16(v0[0], v0[1]); w.y = cvt_pk_bf16(v0[2], v0[3]); w.z = cvt_pk_bf16(v1[0], v1[1]); w.w = cvt_pk_bf16(v1[2], v1[3]);
                        *(u32x4*)(O + ((size_t)((bb * NH + hd0 + 2 * bj) * SEQ + tok)) * 64 + d0) = w; } }
        }
    }
};
struct EpiOut {
    static constexpr bool PERM = true;
    const float* x; bf16_t* out; const float* mod;
    struct Pre { int none; };
    __device__ __forceinline__ void fetch_sync(Pre&, const Unit&, int, int, int, int) const {}
    __device__ __forceinline__ void fetch_async(Pre&, const Unit&, int, int, int, int) const {}
    __device__ __forceinline__ void init(f32x4 (&acc)[2][2][4][2], const Pre&) const { acc_zero(acc); }
    __device__ __forceinline__ void operator()(const f32x4 (&acc)[2][2][4][2], const Unit& u, int wr, int wc, int fr, int fq) const {
        const int b = (u.pm * BM) / SEQ; const float* g1 = mod + b * 6144 + 2048;
        const int col0 = u.pn * BM + wc * 32 + 8 * fq;
        f32x4 gv[2][2];
#pragma unroll
        for (int bj = 0; bj < 2; ++bj)
#pragma unroll
            for (int n = 0; n < 2; ++n) gv[bj][n] = *(const f32x4*)(g1 + col0 + bj * HALF + n * 4);
#pragma unroll
        for (int ai = 0; ai < 2; ++ai) {
            f32x4 xv[4][2][2];
#pragma unroll
            for (int m = 0; m < 4; ++m) { const size_t off = (size_t)(u.pm * BM + ai * HALF + wr * 64 + m * 16 + fr) * D + col0;
#pragma unroll
                for (int bj = 0; bj < 2; ++bj)
#pragma unroll
                    for (int n = 0; n < 2; ++n) xv[m][bj][n] = *(const f32x4*)(x + off + bj * HALF + n * 4); }
            asm volatile("" ::: "memory");
#pragma unroll
            for (int m = 0; m < 4; ++m) { const size_t off = (size_t)(u.pm * BM + ai * HALF + wr * 64 + m * 16 + fr) * D + col0;
#pragma unroll
                for (int bj = 0; bj < 2; ++bj) { const f32x4 v0 = xv[m][bj][0] + gv[bj][0] * acc[ai][bj][m][0], v1 = xv[m][bj][1] + gv[bj][1] * acc[ai][bj][m][1];
                    u32x4 w; w.x = cvt_pk_bf16(v0[0], v0[1]); w.y = cvt_pk_bf16(v0[2], v0[3]); w.z = cvt_pk_bf16(v1[0], v1[1]); w.w = cvt_pk_bf16(v1[2], v1[3]);
                    *(u32x4*)(out + off + bj * HALF) = w; } }
            asm volatile("" ::: "memory");
        }
    }
};
struct EpiSwiglu {
    static constexpr bool PERM = true;
    unsigned char* ACT; const float* b_gu;
    struct Pre { f32x4 v[4]; };
    __device__ __forceinline__ void fetch_sync(Pre& p, const Unit& u, int wr, int wc, int fr, int fq) const {
        const float* bg = b_gu + (size_t)u.e * 2048 + u.pn * HALF + wc * 32 + 8 * fq;
        p.v[0] = *(const f32x4*)(bg); p.v[1] = *(const f32x4*)(bg + 4); p.v[2] = *(const f32x4*)(bg + 1024); p.v[3] = *(const f32x4*)(bg + 1028);
    }
    __device__ __forceinline__ void fetch_async(Pre& p, const Unit& u, int wr, int wc, int fr, int fq) const {
        const float* bg = b_gu + (size_t)u.e * 2048 + u.pn * HALF + wc * 32 + 8 * fq;
        load16_untracked(p.v[0], bg); load16_untracked(p.v[1], bg + 4); load16_untracked(p.v[2], bg + 1024); load16_untracked(p.v[3], bg + 1028);
    }
    __device__ __forceinline__ void init(f32x4 (&acc)[2][2][4][2], const Pre& p) const {
#pragma unroll
        for (int n = 0; n < 2; ++n) { const f32x4 bgv = p.v[n], buv = (p.v[2 + n] + 1.0f) * 4.0f;
#pragma unroll
            for (int ai = 0; ai < 2; ++ai)
#pragma unroll
                for (int m = 0; m < 4; ++m) { acc[ai][0][m][n] = bgv; acc[ai][1][m][n] = buv; } }
    }
    __device__ __forceinline__ void operator()(const f32x4 (&acc)[2][2][4][2], const Unit& u, int wr, int wc, int fr, int fq) const {
        const int cb = u.pn * HALF + wc * 32 + 8 * fq;
#pragma unroll
        for (int ai = 0; ai < 2; ++ai)
#pragma unroll
            for (int m = 0; m < 4; ++m) { const size_t row = (size_t)u.pm * BM + ai * HALF + wr * 64 + m * 16 + fr;
                float a[8];
#pragma unroll
                for (int n = 0; n < 2; ++n)
#pragma unroll
                    for (int jp = 0; jp < 2; ++jp) { f32x2 g, up;
                        g.x = __builtin_amdgcn_fmed3f(acc[ai][0][m][n][2 * jp], -3.0e38f, 7.0f); g.y = __builtin_amdgcn_fmed3f(acc[ai][0][m][n][2 * jp + 1], -3.0e38f, 7.0f);
                        up.x = __builtin_amdgcn_fmed3f(acc[ai][1][m][n][2 * jp], -24.0f, 32.0f); up.y = __builtin_amdgcn_fmed3f(acc[ai][1][m][n][2 * jp + 1], -24.0f, 32.0f);
                        const f32x2 t = g * (-1.702f * 1.4426950408889634f); f32x2 e; e.x = __builtin_amdgcn_exp2f(t.x); e.y = __builtin_amdgcn_exp2f(t.y);
                        const f32x2 d = e + 1.0f; f32x2 r; r.x = __builtin_amdgcn_rcpf(d.x); r.y = __builtin_amdgcn_rcpf(d.y);
                        const f32x2 o = (up * g) * r; a[4 * n + 2 * jp] = o.x; a[4 * n + 2 * jp + 1] = o.y; }
                u32x2 w; w.x = pk4_fp8(a[0], a[1], a[2], a[3]); w.y = pk4_fp8(a[4], a[5], a[6], a[7]);
                *(u32x2*)(ACT + row * D + cb) = w; }
    }
};
struct EpiDown {
    static constexpr bool PERM = true;
    unsigned char* Y; const float* b_down;
    struct Pre { f32x4 v[4]; };
    __device__ __forceinline__ void fetch_sync(Pre& p, const Unit& u, int wr, int wc, int fr, int fq) const {
        const float* bd = b_down + (size_t)u.e * D + u.pn * BM + wc * 32 + 8 * fq;
        p.v[0] = *(const f32x4*)(bd); p.v[1] = *(const f32x4*)(bd + 4); p.v[2] = *(const f32x4*)(bd + HALF); p.v[3] = *(const f32x4*)(bd + HALF + 4);
    }
    __device__ __forceinline__ void fetch_async(Pre& p, const Unit& u, int wr, int wc, int fr, int fq) const {
        const float* bd = b_down + (size_t)u.e * D + u.pn * BM + wc * 32 + 8 * fq;
        load16_untracked(p.v[0], bd); load16_untracked(p.v[1], bd + 4); load16_untracked(p.v[2], bd + HALF); load16_untracked(p.v[3], bd + HALF + 4);
    }
    __device__ __forceinline__ void init(f32x4 (&acc)[2][2][4][2], const Pre& p) const {
#pragma unroll
        for (int bj = 0; bj < 2; ++bj)
#pragma unroll
            for (int n = 0; n < 2; ++n) { const f32x4 bv = p.v[2 * bj + n];
#pragma unroll
                for (int ai = 0; ai < 2; ++ai)
#pragma unroll
                    for (int m = 0; m < 4; ++m) acc[ai][bj][m][n] = bv; }
    }
    __device__ __forceinline__ void operator()(const f32x4 (&acc)[2][2][4][2], const Unit& u, int wr, int wc, int fr, int fq) const {
        const int col0 = u.pn * BM + wc * 32 + 8 * fq;
#pragma unroll
        for (int ai = 0; ai < 2; ++ai)
#pragma unroll
            for (int m = 0; m < 4; ++m) { unsigned char* rowp = Y + ((size_t)u.pm * BM + ai * HALF + wr * 64 + m * 16 + fr) * D + col0;
#pragma unroll
                for (int bj = 0; bj < 2; ++bj) { const f32x4 v0 = acc[ai][bj][m][0] * 16.0f, v1 = acc[ai][bj][m][1] * 16.0f;
                    u32x2 w; w.x = pk4_fp8(v0[0], v0[1], v0[2], v0[3]); w.y = pk4_fp8(v1[0], v1[1], v1[2], v1[3]);
                    *(u32x2*)(rowp + bj * HALF) = w; } }
    }
};
}

#define XB_TMO      128
#define XB_XCNT(j)  (256  + 64 * (j))
#define XB_XSUB(j)  (1280 + 64 * (j))
#define XB_XGEN(j)  (2304 + 64 * (j))
#define XB_TOP      3328
#define XB_TOPGEN   3392
#define XCD_BAR_WORDS 3456
#define XB_SPIN_CAP (1u << 18)
__device__ __forceinline__ unsigned xb_ld(unsigned* p)              { return __hip_atomic_load(p, __ATOMIC_RELAXED, __HIP_MEMORY_SCOPE_AGENT); }
__device__ __forceinline__ unsigned xb_add(unsigned* p, unsigned v) { return __hip_atomic_fetch_add(p, v, __ATOMIC_RELAXED, __HIP_MEMORY_SCOPE_AGENT); }
__device__ __forceinline__ unsigned xb_xcc_id() { return (unsigned)__builtin_amdgcn_s_getreg((3 << 11) | 20) & 0xFu; }
#define XB_SPIN(cond, bar) do { unsigned _sp = 0; while (cond) { __builtin_amdgcn_s_sleep(1); \
    if ((++_sp & 255u) == 0u) { if (xb_ld(&(bar)[XB_TMO])) break; if (_sp > XB_SPIN_CAP) { atomicAdd(&(bar)[XB_TMO], 1u); break; } } } } while (0)
struct XcdBarrier { unsigned* bar; unsigned x; volatile LAS unsigned* st; };
__device__ __forceinline__ XcdBarrier xcd_barrier_post(unsigned* bar, volatile LAS unsigned* st) {
    XcdBarrier b; b.bar = bar; b.x = xb_xcc_id(); b.st = st;
    if (threadIdx.x == 0) (void)xb_add(&bar[XB_XCNT(b.x)], 1u);
    return b;
}
__device__ __forceinline__ void xcd_barrier_complete(unsigned* bar, unsigned x, unsigned& nloc, unsigned& nx) {
    const unsigned G = gridDim.x * gridDim.y * gridDim.z;
    unsigned sum, cnt, mine, sp = 0u;
    for (;;) {
        sum = 0u; cnt = 0u; mine = 0u;
#pragma unroll
        for (unsigned j = 0; j < 16; ++j) { const unsigned c = xb_ld(&bar[XB_XCNT(j)]); sum += c; cnt += (c > 0u) ? 1u : 0u; mine = (j == x) ? c : mine; }
        if (sum == G) break;
        __builtin_amdgcn_s_sleep(1);
        if ((++sp & 255u) == 0u) { if (xb_ld(&bar[XB_TMO])) break; if (sp > XB_SPIN_CAP) { atomicAdd(&bar[XB_TMO], 1u); break; } }
    }
    nloc = mine > 0u ? mine : 1u; nx = cnt > 0u ? cnt : 1u;
}
__device__ __forceinline__ void xcd_barrier(const XcdBarrier& b) {
    asm volatile("s_waitcnt vmcnt(0)" ::: "memory");
    __syncthreads();
    if (threadIdx.x == 0) {
        unsigned* bar = b.bar;
        __builtin_amdgcn_s_waitcnt(0);
        unsigned nloc = b.st[0], nx = b.st[1];
        if (nloc == 0u) { xcd_barrier_complete(bar, b.x, nloc, nx); b.st[0] = nloc; b.st[1] = nx; }
        const unsigned old = xb_add(&bar[XB_XSUB(b.x)], 1u);
        const unsigned gen = old / nloc;
        if (old + 1u == (gen + 1u) * nloc) {
            __builtin_amdgcn_fence(__ATOMIC_RELEASE, "agent");
            asm volatile("s_waitcnt vmcnt(0)" ::: "memory");
            const unsigned og = xb_add(&bar[XB_TOP], 1u);
            const unsigned tg = og / nx;
            if (og + 1u == (tg + 1u) * nx) xb_add(&bar[XB_TOPGEN], 1u);
            else XB_SPIN(xb_ld(&bar[XB_TOPGEN]) == tg, bar);
            __builtin_amdgcn_fence(__ATOMIC_ACQUIRE, "agent");
            xb_add(&bar[XB_XGEN(b.x)], 1u);
            asm volatile("s_waitcnt vmcnt(0)" ::: "memory");
        } else {
            XB_SPIN(xb_ld(&bar[XB_XGEN(b.x)]) == gen, bar);
            __builtin_amdgcn_fence(__ATOMIC_ACQUIRE, "agent");
            asm volatile("s_waitcnt vmcnt(0)" ::: "memory");
        }
    }
    __syncthreads();
}

struct Args {
    const float* x; const float* c; const int* pos; const float* w_ada; const float* b_ada; const float* g_mix; const float* w_in;
    const float* conv_w; const float* conv_b; const float* ln_g; const float* ln_b; const float* w_out; const float* g_ffn;
    const float* w_router; const float* b_router; const float* w_gu; const float* b_gu; const float* w_down; const float* b_down; const float* g_final;
    float* out; unsigned char* ws; int ph_lo, ph_hi;
};
struct Frame {
    LAS unsigned char* lds; int tid, lane, wave, G, blk;
};

__device__ __forceinline__ void transpose_item(const float* W, int N, bf16_t* WT, int k0, int n0, int srccol, LAS float* scr, int lane) {
    float tv_[32];
#pragma unroll
    for (int i = 0; i < 32; ++i) tv_[i] = W[(size_t)(k0 + 2 * i + (lane >> 5)) * N + srccol];
#pragma unroll
    for (int i = 0; i < 32; ++i) scr[(2 * i + (lane >> 5)) * 33 + (lane & 31)] = tv_[i];
    asm volatile("s_waitcnt lgkmcnt(0)" ::: "memory");
    const int c = lane & 7;
#pragma unroll
    for (int j = 0; j < 4; ++j) { const int n = (lane >> 3) + 8 * j; const LAS float* s = scr + (8 * c) * 33 + n;
        u32x4 o; o.x = pk2(s[0 * 33], s[1 * 33]); o.y = pk2(s[2 * 33], s[3 * 33]); o.z = pk2(s[4 * 33], s[5 * 33]); o.w = pk2(s[6 * 33], s[7 * 33]);
        *(u32x4*)(WT + (size_t)(n0 + n) * 1024 + k0 + 8 * c) = o; }
    asm volatile("s_waitcnt lgkmcnt(0)" ::: "memory");
}
__device__ __forceinline__ int srccol_in(int n) {
    if (n < 1024) { const int t = n >> 8, w = n & 255; return w < 128 ? 128 * t + w : 512 + 128 * t + (w - 128); }
    if (n < 2048) { const int p = n & 63; return (n & ~63) + (p < 16 ? 4 * (p >> 3) + (p & 3) + 8 * ((p >> 2) & 1) : p); }
    return n;
}
__device__ __forceinline__ int srccol_gu(int n) { const int t = n >> 8, w = n & 255; return w < 128 ? 128 * t + w : 1024 + 128 * t + (w - 128); }

__device__ __forceinline__ void transpose_item_f8(const float* W, int N, unsigned char* WT, int k0, int n0, int srccol, LAS float* scr, int lane) {
    float tv_[32];
#pragma unroll
    for (int i = 0; i < 32; ++i) tv_[i] = W[(size_t)(k0 + 2 * i + (lane >> 5)) * N + srccol];
#pragma unroll
    for (int i = 0; i < 32; ++i) scr[(2 * i + (lane >> 5)) * 33 + (lane & 31)] = tv_[i];
    asm volatile("s_waitcnt lgkmcnt(0)" ::: "memory");
    const int c = lane & 7;
#pragma unroll
    for (int j = 0; j < 4; ++j) { const int n = (lane >> 3) + 8 * j; const LAS float* s = scr + (8 * c) * 33 + n;
        u32x2 o; o.x = pk4_fp8(64.0f * s[0 * 33], 64.0f * s[1 * 33], 64.0f * s[2 * 33], 64.0f * s[3 * 33]); o.y = pk4_fp8(64.0f * s[4 * 33], 64.0f * s[5 * 33], 64.0f * s[6 * 33], 64.0f * s[7 * 33]);
        *(u32x2*)(WT + (size_t)(n0 + n) * 1024 + k0 + 8 * c) = o; }
    asm volatile("s_waitcnt lgkmcnt(0)" ::: "memory");
}
__device__ __forceinline__ void p0_mod_gemv(const Args& a, Frame& F) {
    unsigned char* ws = a.ws;
    LAS float* cact = (LAS float*)F.lds;
    LAS float* part = (LAS float*)(F.lds + 16384);
    const int r8 = F.lane >> 3, c4 = F.lane & 7;
    const float* wp = a.w_ada + (size_t)(F.wave * 128 + r8) * 6144 + F.blk * 32 + 4 * c4;
    f32x4 wv[16];
#pragma unroll
    for (int i = 0; i < 16; ++i) wv[i] = *(const f32x4*)(wp + (size_t)(8 * i) * 6144);
    { const f32x4 c0 = *(const f32x4*)(a.c + 8 * F.tid), c1 = *(const f32x4*)(a.c + 8 * F.tid + 4);
      f32x4 s0, s1;
#pragma unroll
      for (int q = 0; q < 4; ++q) { s0[q] = c0[q] / (1.0f + __expf(-c0[q])); s1[q] = c1[q] / (1.0f + __expf(-c1[q])); }
      *(LAS f32x4*)(cact + 8 * F.tid) = s0; *(LAS f32x4*)(cact + 8 * F.tid + 4) = s1; }
    __syncthreads();
    f32x4 acc[4];
#pragma unroll
    for (int bb = 0; bb < 4; ++bb) acc[bb] = (f32x4){0.f, 0.f, 0.f, 0.f};
#pragma unroll
    for (int i = 0; i < 16; ++i) { const int k = F.wave * 128 + 8 * i + r8;
#pragma unroll
        for (int bb = 0; bb < 4; ++bb) acc[bb] += wv[i] * cact[bb * 1024 + k]; }
#pragma unroll
    for (int bb = 0; bb < 4; ++bb)
#pragma unroll
        for (int q = 0; q < 4; ++q) { float v = acc[bb][q]; v += __shfl_xor(v, 8); v += __shfl_xor(v, 16); v += __shfl_xor(v, 32); acc[bb][q] = v; }
    if (F.lane < 8) {
#pragma unroll
        for (int bb = 0; bb < 4; ++bb) *(LAS f32x4*)(part + (F.wave * 4 + bb) * 32 + 4 * c4) = acc[bb]; }
    __syncthreads();
    if (F.tid < 128) { const int bb = F.tid >> 5, l = F.tid & 31; float sum = a.b_ada[F.blk * 32 + l];
#pragma unroll
        for (int w = 0; w < 8; ++w) sum += part[(w * 4 + bb) * 32 + l];
        ((float*)(ws + WS_MOD))[bb * 6144 + F.blk * 32 + l] = sum; }
    __syncthreads();
}
__device__ __forceinline__ void p0_prologue(const Args& a, Frame& F) {
    unsigned char* ws = a.ws;
    LAS float* scr = (LAS float*)(F.lds + F.wave * 16384);
    const bool split = F.G >= 192 + 32;
    if (split ? (F.blk < 192) : true) { if (split) p0_mod_gemv(a, F); }
    const int blk2 = split ? (int)((F.blk + F.G - 192) % F.G) : (int)F.blk;
    const int gw = blk2 * 8 + F.wave, NGW = F.G * 8;
    constexpr int I_IN = 16 * 80, I_OUT = 16 * 32, I_GU1 = 16 * 64, I_GU = 32 * I_GU1, I_DN1 = 16 * 32, I_DN = 32 * I_DN1;
    constexpr int NITEMS = I_IN + I_OUT + I_GU + I_DN;
    for (int it = gw; it < (BG_IN_ATTN ? I_IN + I_OUT : NITEMS); it += NGW) {
        int r = it;
        if (BG_IN_ATTN) r += I_GU + I_DN;
        if (r < I_GU) { const int e = r / I_GU1, q = r % I_GU1, kb = q / 64, nb = q % 64; const int n = nb * 32 + (F.lane & 31);
            transpose_item_f8(a.w_gu + (size_t)e * 1024 * 2048, 2048, ws + WS_WGU + (size_t)e * 2048 * 1024, kb * 64, nb * 32, srccol_gu(n), scr, F.lane); continue; }
        r -= I_GU;
        if (r < I_DN) { const int e = r / I_DN1, q = r % I_DN1, kb = q / 32, nb = q % 32;
            transpose_item_f8(a.w_down + (size_t)e * 1024 * 1024, 1024, ws + WS_WDOWN + (size_t)e * 1024 * 1024, kb * 64, nb * 32, nb * 32 + (F.lane & 31), scr, F.lane); continue; }
        r -= I_DN;
        if (r < I_IN) { const int kb = r / 80, nb = r % 80;
            transpose_item(a.w_in, INC, (bf16_t*)(ws + WS_WIN), kb * 64, nb * 32, FUSE_SPLIT ? srccol_in(nb * 32 + (F.lane & 31)) : nb * 32 + (F.lane & 31), scr, F.lane); continue; }
        r -= I_IN;
        { const int kb = r / 32, nb = r % 32;
            transpose_item(a.w_out, 1024, (bf16_t*)(ws + WS_WOUT), kb * 64, nb * 32, nb * 32 + (F.lane & 31), scr, F.lane); }
    }
    {
        const float inv_freq[8] = {1.0f, 0.19392274474868576f, 0.03760603093086393f, 0.007292664737217109f, 0.001414213562373095f, 0.0002742481756762073f, 5.318295896944988e-05f, 1.031338537721246e-05f};
        float* rope = (float*)(ws + WS_ROPE);
        for (int idx = blk2 * 512 + F.tid; idx < T * 8; idx += (int)F.G * 512) {
            const int tkn = idx >> 3, i = idx & 7;
            float fr = 1.0f;
#pragma unroll
            for (int q = 0; q < 8; ++q) fr = (i == q) ? inv_freq[q] : fr;
            const float angf = (float)a.pos[tkn] * fr;
            const double ang = (double)angf;
            const double kq = __builtin_rint(ang * 0.63661977236758134308);
            const double y = (ang - kq * 1.57079632679489655800) - kq * 6.123233995736766036e-17;
            const double y2 = y * y;
            const double sn = y * (1.0 + y2 * (-1.0 / 6 + y2 * (1.0 / 120 + y2 * (-1.0 / 5040 + y2 * (1.0 / 362880 + y2 * (-1.0 / 39916800 + y2 * (1.0 / 6227020800.0)))))));
            const double cs = 1.0 + y2 * (-0.5 + y2 * (1.0 / 24 + y2 * (-1.0 / 720 + y2 * (1.0 / 40320 + y2 * (-1.0 / 3628800 + y2 * (1.0 / 479001600.0 + y2 * (-1.0 / 87178291200.0)))))));
            const int qd = ((int)kq) & 3;
            const double c_ = (qd == 0) ? cs : (qd == 1) ? -sn : (qd == 2) ? -cs : sn;
            const double s_ = (qd == 0) ? sn : (qd == 1) ? cs : (qd == 2) ? -sn : -cs;
            rope[tkn * 16 + i] = (float)c_; rope[tkn * 16 + 8 + i] = (float)s_;
        }
    }
    if (!split) { __syncthreads(); for (int g = 0; g < 192; ++g) { Frame F2 = F; F2.blk = g; p0_mod_gemv(a, F2); } }
}

__device__ __forceinline__ void p1_norm1(const Args& a, Frame& F) {
    const float* mod = (const float*)(a.ws + WS_MOD);
    bf16_t* H = (bf16_t*)(a.ws + WS_H);
    const int gw = F.blk * 8 + F.wave, NGW = F.G * 8;
    f32x4 gm[4];
#pragma unroll
    for (int j = 0; j < 4; ++j) gm[j] = *(const f32x4*)(a.g_mix + 4 * F.lane + 256 * j);
#pragma unroll 1
    for (int m0 = 2 * gw; m0 < T; m0 += 2 * NGW) {
        const int b = m0 / SEQ;
        f32x4 v[2][4], shv[4], scv[4]; float ss[2];
#pragma unroll
        for (int t = 0; t < 2; ++t) { const f32x4* xr = (const f32x4*)(a.x + (size_t)(m0 + t) * D) + F.lane;
#pragma unroll
            for (int j = 0; j < 4; ++j) v[t][j] = xr[64 * j]; }
#pragma unroll
        for (int j = 0; j < 4; ++j) { const int col = 4 * F.lane + 256 * j; shv[j] = *(const f32x4*)(mod + b * 6144 + col); scv[j] = *(const f32x4*)(mod + b * 6144 + 1024 + col); }
#pragma unroll
        for (int t = 0; t < 2; ++t) { float s = 0.f;
#pragma unroll
            for (int j = 0; j < 4; ++j) s += (v[t][j].x * v[t][j].x + v[t][j].y * v[t][j].y) + (v[t][j].z * v[t][j].z + v[t][j].w * v[t][j].w);
            ss[t] = s; }
#pragma unroll
        for (int t = 0; t < 2; ++t) {
            const float rstd = 1.0f / sqrtf(wave_sum(ss[t]) * (1.0f / D) + NORM_EPS);
            u32x2* o8 = (u32x2*)(H + (size_t)(m0 + t) * D) + F.lane;
#pragma unroll
            for (int j = 0; j < 4; ++j) { const f32x4 h = (v[t][j] * rstd * gm[j]) * (scv[j] + 1.0f) + shv[j];
                u32x2 w; w.x = pk2(h.x, h.y); w.y = pk2(h.z, h.w); o8[64 * j] = w; } }
    }
}

__device__ __forceinline__ void p3_split(const Args& a, Frame& F) {
    const bf16_t* PR = (const bf16_t*)(a.ws + WS_PROJ);
    bf16_t* U = (bf16_t*)(a.ws + WS_U); bf16_t* Q = (bf16_t*)(a.ws + WS_Q); bf16_t* K = (bf16_t*)(a.ws + WS_K); bf16_t* V = (bf16_t*)(a.ws + WS_V);
    const float* rope = (const float*)(a.ws + WS_ROPE);
    const int gw = F.blk * 8 + F.wave, NGW = F.G * 8, l = F.lane;
    for (int m = gw; m < T; m += NGW) {
        const bf16_t* pr = PR + (size_t)m * INC;
        const u32x4 av = *(const u32x4*)(pr + 8 * l), gv = *(const u32x4*)(pr + 512 + 8 * l);
        u32x4 uo;
#pragma unroll
        for (int j = 0; j < 4; ++j) { const float a0 = bf_lo(av[j]), a1 = bf_hi(av[j]), g0 = bf_lo(gv[j]), g1 = bf_hi(gv[j]);
            uo[j] = pk2(a0 * fast_sigmoid(g0), a1 * fast_sigmoid(g1)); }
        *(u32x4*)(U + (size_t)m * 512 + 8 * l) = uo;
        const f32x4 c0 = *(const f32x4*)(rope + m * 16), c1 = *(const f32x4*)(rope + m * 16 + 4), s0 = *(const f32x4*)(rope + m * 16 + 8), s1 = *(const f32x4*)(rope + m * 16 + 12);
        const float cs[8] = {c0.x, c0.y, c0.z, c0.w, c1.x, c1.y, c1.z, c1.w}, sn[8] = {s0.x, s0.y, s0.z, s0.w, s1.x, s1.y, s1.z, s1.w};
#pragma unroll
        for (int which = 0; which < 2; ++which) {
            const u32x4 qv = *(const u32x4*)(pr + 1024 + 512 * which + 8 * l);
            float xv[8], ov[8];
#pragma unroll
            for (int j = 0; j < 4; ++j) { xv[2 * j] = bf_lo(qv[j]); xv[2 * j + 1] = bf_hi(qv[j]); }
#pragma unroll
            for (int i = 0; i < 8; ++i) ov[i] = __shfl_xor(xv[i], 1);
            const int sel = l & 7;
            u32x4 qo;
#pragma unroll
            for (int j = 0; j < 4; ++j) {
                float r0 = xv[2 * j], r1 = xv[2 * j + 1];
                if (sel == 0) { r0 = xv[2 * j] * cs[2 * j] - ov[2 * j] * sn[2 * j]; r1 = xv[2 * j + 1] * cs[2 * j + 1] - ov[2 * j + 1] * sn[2 * j + 1]; }
                else if (sel == 1) { r0 = xv[2 * j] * cs[2 * j] + ov[2 * j] * sn[2 * j]; r1 = xv[2 * j + 1] * cs[2 * j + 1] + ov[2 * j + 1] * sn[2 * j + 1]; }
                qo[j] = pk2(r0, r1); }
            *(u32x4*)((which ? K : Q) + (size_t)m * 512 + 8 * l) = qo;
        }
        *(u32x4*)(V + (size_t)m * 512 + 8 * l) = *(const u32x4*)(pr + 2048 + 8 * l);
    }
}

__device__ __forceinline__ void conv_unit(const Args& a, Frame& F, int cu, const f32x2 (&wgt)[31], f32x2 bias) {
    const bf16_t* U = (const bf16_t*)(a.ws + WS_U); bf16_t* MIX = (bf16_t*)(a.ws + WS_MIX);
    const int b = cu / 128, t0 = (cu % 128) * 64;
    const int half = F.wave >> 2, cq = F.wave & 3, c0 = 128 * cq + 2 * F.lane;
    const int ts = t0 + 32 * half;
    const bf16_t* Ub = U + (size_t)b * SEQ * 512 + c0;
    LAS float* yt = (LAS float*)F.lds;
    unsigned rawA[31], rawB[31];
#pragma unroll
    for (int jj = 0; jj < 31; ++jj) { const int tin = ts - 30 + jj; const int tc = tin < 0 ? 0 : tin; const unsigned r = *(const unsigned*)(Ub + (size_t)tc * 512); rawA[jj] = tin < 0 ? 0u : r; }
#pragma unroll
    for (int jj = 0; jj < 31; ++jj) rawB[jj] = *(const unsigned*)(Ub + (size_t)(ts + 1 + jj) * 512);
    f32x2 win[31];
#pragma unroll 1
    for (int o = 0; o < 2; ++o) {
#pragma unroll
        for (int jj = 0; jj < 31; ++jj) {
            const int j = 31 * o + jj;
            const unsigned raw = o ? rawB[jj] : rawA[jj];
            f32x2 v; v.x = bf_lo(raw); v.y = bf_hi(raw);
            win[jj] = v;
            if (j >= 30) { f32x2 acc = bias;
#pragma unroll
                for (int tap = 0; tap < 31; ++tap) acc += wgt[tap] * win[(jj + 1 + tap) % 31];
                *(LAS f32x2*)(yt + (32 * half + j - 30) * 512 + c0) = acc; }
        }
    }
    __syncthreads();
    const f32x4 g0 = *(const f32x4*)(a.ln_g + 4 * F.lane), g1 = *(const f32x4*)(a.ln_g + 256 + 4 * F.lane), b0 = *(const f32x4*)(a.ln_b + 4 * F.lane), b1 = *(const f32x4*)(a.ln_b + 256 + 4 * F.lane);
#pragma unroll 1
    for (int i = 0; i < 8; ++i) { const int tl = 8 * F.wave + i; const LAS float* row = yt + tl * 512;
        f32x4 v0 = *(const LAS f32x4*)(row + 4 * F.lane), v1 = *(const LAS f32x4*)(row + 256 + 4 * F.lane);
        const float mean = wave_sum((v0.x + v0.y) + (v0.z + v0.w) + (v1.x + v1.y) + (v1.z + v1.w)) * (1.0f / 512.0f);
        v0 = v0 - mean; v1 = v1 - mean;
        const float var = wave_sum((v0.x * v0.x + v0.y * v0.y) + (v0.z * v0.z + v0.w * v0.w) + (v1.x * v1.x + v1.y * v1.y) + (v1.z * v1.z + v1.w * v1.w)) * (1.0f / 512.0f);
        const float rstd = 1.0f / sqrtf(var + NORM_EPS);
        f32x4 y0 = v0 * rstd * g0 + b0, y1 = v1 * rstd * g1 + b1;
#pragma unroll
        for (int q = 0; q < 4; ++q) { y0[q] = y0[q] * fast_sigmoid(y0[q]); y1[q] = y1[q] * fast_sigmoid(y1[q]); }
        bf16_t* orow = MIX + ((size_t)b * SEQ + t0 + tl) * D;
        u32x2 w0, w1; w0.x = pk2(y0.x, y0.y); w0.y = pk2(y0.z, y0.w); w1.x = pk2(y1.x, y1.y); w1.y = pk2(y1.z, y1.w);
        *(u32x2*)(orow + 4 * F.lane) = w0; *(u32x2*)(orow + 256 + 4 * F.lane) = w1; }
    __syncthreads();
}
__device__ __forceinline__ void p4_conv(const Args& a, Frame& F) {
    const int cq = F.wave & 3, c0 = 128 * cq + 2 * F.lane;
    f32x2 wgt[31];
#pragma unroll
    for (int j = 0; j < 31; ++j) wgt[j] = *(const f32x2*)(a.conv_w + j * 512 + c0);
    const f32x2 bias = *(const f32x2*)(a.conv_b + c0);
    for (int cu = F.blk; cu < 512; cu += F.G) conv_unit(a, F, cu, wgt, bias);
}

namespace att {
constexpr int ST_OFF = 0, ML_OFF = 65536, VB_OFF = 69632;
constexpr float CSC = 0.125f * 1.4426950408889634f;
__device__ __forceinline__ unsigned st_addr(int row, int ch8) { const int swz = (row & 15) ^ ((row >> 4) & 15); return (unsigned)(ST_OFF + row * 128 + ((ch8 ^ swz) << 3)); }


#ifndef BG_CVT_SCALE
#define BG_CVT_SCALE 0.015625f
#endif
constexpr int BG_ITEMS = 65536 + 32768;
constexpr int BG_OFF = 102400;
__device__ __forceinline__ void bg_decode(const Args& a, int it, int lane, const float*& W, int& N, unsigned char*& dst, int& k0, int& n0, int& src) {
    if (it < 65536) { const int e = it >> 11, q = it & 2047, kb = q >> 6, nb = q & 63; W = a.w_gu + (size_t)e * 1024 * 2048; N = 2048; dst = a.ws + WS_WGU + (size_t)e * 2048 * 1024; k0 = kb * 32; n0 = nb * 32; src = srccol_gu(n0 + (lane & 31)); }
    else { const int r = it - 65536, e = r >> 10, q = r & 1023, kb = q >> 5, nb = q & 31; W = a.w_down + (size_t)e * 1024 * 1024; N = 1024; dst = a.ws + WS_WDOWN + (size_t)e * 1024 * 1024; k0 = kb * 32; n0 = nb * 32; src = n0 + (lane & 31); }
}
__device__ __forceinline__ void bg_issue(const Args& a, int it_, int lane, float (&tmp)[16]) {
    const int it0 = __builtin_amdgcn_readfirstlane(it_);
    const bool valid = it0 < BG_ITEMS; const int it = valid ? it0 : 0;
    const float* W; int N, k0, n0, src; unsigned char* dst; bg_decode(a, it, lane, W, N, dst, k0, n0, src);
    const unsigned boff = (unsigned)((lane >> 5) * 16 * N + src) * 4u;
    const __amdgpu_buffer_rsrc_t rs = __builtin_amdgcn_make_buffer_rsrc((void*)W, 0, valid ? (int)(1024u * 2048u * 4u) : 0, 0x00020000);
#pragma unroll
    for (int i = 0; i < 16; ++i) tmp[i] = __builtin_bit_cast(float, __builtin_amdgcn_raw_buffer_load_b32(rs, (int)boff, (k0 + i) * N * 4, 2  ));
}
__device__ __forceinline__ void bg_finish(const Args& a, int it_, int lane, const float (&tmp)[16], LAS float* scr) {
    const int it0 = __builtin_amdgcn_readfirstlane(it_);
    const bool valid = it0 < BG_ITEMS; const int it = valid ? it0 : 0;
    const float* W; int N, k0, n0, src; unsigned char* dst; bg_decode(a, it, lane, W, N, dst, k0, n0, src);
    u32x4 o;
#pragma unroll
    for (int q = 0; q < 4; ++q) { typedef short v2s_ __attribute__((ext_vector_type(2))); v2s_ r = {0, 0};
        r = __builtin_amdgcn_cvt_scalef32_pk_fp8_f32(r, tmp[4 * q], tmp[4 * q + 1], BG_CVT_SCALE, false); r = __builtin_amdgcn_cvt_scalef32_pk_fp8_f32(r, tmp[4 * q + 2], tmp[4 * q + 3], BG_CVT_SCALE, true);
        o[q] = __builtin_bit_cast(unsigned, r); }
    const __amdgpu_buffer_rsrc_t rd = __builtin_amdgcn_make_buffer_rsrc((void*)dst, 0, valid ? (int)(2048u * 1024u) : 0, 0x00020000);
    __builtin_amdgcn_raw_buffer_store_b128(o, rd, (n0 + (lane & 31)) * 1024 + k0 + 16 * (lane >> 5), 0, 0);
}
#define BG_STEP(X) do { bg_finish(a, bg.it##X - bg_stride, lane, bg.tmp##X, bg_scr); bg_issue(a, bg.it##X, lane, bg.tmp##X); bg.it##X += bg_stride; } while (0)
struct BgState { int itA, itB, liveA, liveB; float tmpA[16], tmpB[16]; };

template <int STAGE, int DIL>
__device__ __forceinline__ void wave_tile(const Args& a, BgState& bg, int bg_stride, const bf16_t* Q, const bf16_t* K, const bf16_t* V, bf16_t* MIX, int b, int h, int T0, int tq0, LAS unsigned char* lds, int wave, int lane) {
    LAS float* bg_scr = (LAS float*)(lds + BG_OFF + wave * 4224);
    const int n = lane & 31, hh = lane >> 5;
    const size_t rowb = (size_t)b * SEQ;
    const int tq = tq0 + DIL * n;
    const size_t hrow = (size_t)(b * NH + h) * SEQ;
    const bf16_t* qp = Q + (hrow + tq) * 64 + 8 * hh;
    bf16x8 qf[4];
#pragma unroll
    for (int s = 0; s < 4; ++s) qf[s] = *(const bf16x8*)(qp + 16 * s);
    int jmin = 128 - tq0 / DIL; jmin = jmin < 0 ? 0 : jmin;
    const int kt_min = jmin >> 5;
    f32x16 o0, o1;
#pragma unroll
    for (int r = 0; r < 16; ++r) { o0[r] = 0.f; o1[r] = 0.f; }
    float mrun = -1e30f, lrun = 0.f;
    LAS unsigned char* vb = lds + VB_OFF + wave * 8192;
    const int tk0 = tq0 - 128 * DIL;
    const int blk = (lane >> 4) & 1, q4 = (lane & 15) >> 2, p4 = lane & 3, n4 = n - 4 * hh;
    const bf16_t* Kl = K + hrow * 64 + 8 * hh;
    const bf16_t* Vl = V + hrow * 64;
    bf16x8 kfA[4], kfB[4]; u32x4 vv[4];
#define ATT_ISSUE_K(KT, KF) do { int tk_ = tk0 + DIL * (32 * (KT) + n); tk_ = tk_ < 0 ? 0 : tk_; const bf16_t* kp_ = Kl + (size_t)tk_ * 64; \
        _Pragma("unroll") for (int s = 0; s < 4; ++s) KF[s] = *(const bf16x8*)(kp_ + 16 * s); } while (0)
#define ATT_ISSUE_V(KT, VV) do { _Pragma("unroll") for (int c = 0; c < 4; ++c) { const int row_ = 8 * c + (lane >> 3), pos_ = lane & 7, ch_ = pos_ ^ (((row_ >> 1) & 1) << 2); \
            int tv_ = tk0 + DIL * (32 * (KT) + row_); tv_ = tv_ < 0 ? 0 : tv_; VV[c] = *(const u32x4*)(Vl + (size_t)tv_ * 64 + ch_ * 8); } } while (0)
#define ATT_TILE(KT, KF, BUF) do { \
        _Pragma("unroll") for (int c = 0; c < 4; ++c) *(LAS u32x4*)(vb + (BUF) * 4096 + c * 1024 + lane * 16) = vv[c]; \
        if ((KT) > 0) ATT_ISSUE_V((KT) - 1, vv); \
        f32x16 st; _Pragma("unroll") for (int r = 0; r < 16; ++r) st[r] = 0.f; \
        _Pragma("unroll") for (int s = 0; s < 4; ++s) st = __builtin_amdgcn_mfma_f32_32x32x16_bf16(KF[s], qf[s], st, 0, 0, 0); \
        if ((KT) == 4) { _Pragma("unroll") for (int r = 0; r < 16; ++r) st[r] = ((r & 3) + 8 * (r >> 2) <= n4) ? st[r] : -3.0e38f; }            \
        else if ((KT) == 0 || jmin > 32 * (KT)) { const int lo4 = ((KT) == 0 ? (jmin > n ? jmin : n) : jmin - 32 * (KT)) - 4 * hh; \
            _Pragma("unroll") for (int r = 0; r < 16; ++r) st[r] = ((r & 3) + 8 * (r >> 2) >= lo4) ? st[r] : -3.0e38f; } \
        float mx = fmaxf(fmaxf(st[0], st[1]), fmaxf(st[2], st[3])); \
        _Pragma("unroll") for (int r = 4; r < 16; r += 4) mx = fmaxf(mx, fmaxf(fmaxf(st[r], st[r + 1]), fmaxf(st[r + 2], st[r + 3]))); \
        mx *= CSC;                                    \
        if (__any(mx > mrun + 8.0f)) { mx = fmaxf(mx, __shfl_xor(mx, 32)); const float mnew = fmaxf(mrun, mx), alpha = __builtin_amdgcn_exp2f(mrun - mnew); lrun *= alpha; mrun = mnew; \
            _Pragma("unroll") for (int r = 0; r < 16; ++r) { o0[r] *= alpha; o1[r] *= alpha; } } \
        float pp[16]; float ls = 0.f; \
        _Pragma("unroll") for (int r = 0; r < 16; ++r) { pp[r] = __builtin_amdgcn_exp2f(__builtin_fmaf(st[r], CSC, -mrun)); ls += pp[r]; } \
        lrun += ls; \
        bf16x8 pb[2]; \
        _Pragma("unroll") for (int s2 = 0; s2 < 2; ++s2) { u32x4 w; w.x = cvt_pk_bf16(pp[8 * s2 + 0], pp[8 * s2 + 1]); w.y = cvt_pk_bf16(pp[8 * s2 + 2], pp[8 * s2 + 3]); w.z = cvt_pk_bf16(pp[8 * s2 + 4], pp[8 * s2 + 5]); w.w = cvt_pk_bf16(pp[8 * s2 + 6], pp[8 * s2 + 7]); \
            pb[s2] = __builtin_bit_cast(bf16x8, w); } \
        _Pragma("unroll") for (int db = 0; db < 2; ++db) _Pragma("unroll") for (int s2 = 0; s2 < 2; ++s2) { \
            const s16x4 lo = __builtin_bit_cast(s16x4, __builtin_amdgcn_ds_read_tr16_b64_v4i16((LAS s16x4*)((db ? vtr1 : vtr0) + (BUF) * 4096 + s2 * 2048))); \
            const s16x4 hi = __builtin_bit_cast(s16x4, __builtin_amdgcn_ds_read_tr16_b64_v4i16((LAS s16x4*)((db ? vtr1 : vtr0) + (BUF) * 4096 + s2 * 2048 + 1024))); \
            const bf16x8 vf = (bf16x8){lo[0], lo[1], lo[2], lo[3], hi[0], hi[1], hi[2], hi[3]}; \
            if (db == 0) o0 = __builtin_amdgcn_mfma_f32_32x32x16_bf16(vf, pb[s2], o0, 0, 0, 0); else o1 = __builtin_amdgcn_mfma_f32_32x32x16_bf16(vf, pb[s2], o1, 0, 0, 0); } \
        __builtin_amdgcn_sched_barrier(0); } while (0)
    LAS unsigned char* vtr0; LAS unsigned char* vtr1;
    { const int row = 4 * hh + q4, ch = 2 * blk + (p4 >> 1); const int off = row * 128 + ((ch ^ (((row >> 1) & 1) << 2)) << 4) + 8 * (p4 & 1); vtr0 = vb + off; vtr1 = vb + (off ^ 64); }
    ATT_ISSUE_K(4, kfA); ATT_ISSUE_V(4, vv); ATT_ISSUE_K(3, kfB);
    __builtin_amdgcn_sched_barrier(0);
    ATT_TILE(4, kfA, 0); ATT_ISSUE_K(2, kfA);
    BG_STEP(A);
    ATT_TILE(3, kfB, 1); ATT_ISSUE_K(1, kfB);
    BG_STEP(B);
    ATT_TILE(2, kfA, 0); ATT_ISSUE_K(0, kfA);
    BG_STEP(A);
    ATT_TILE(1, kfB, 1);
    ATT_TILE(0, kfA, 0);
    BG_STEP(B);
#undef ATT_ISSUE_K
#undef ATT_ISSUE_V
#undef ATT_TILE
    const float ltot = lrun + __shfl_xor(lrun, 32);
    const int row = tq - T0;
    LAS f32x2* ml = (LAS f32x2*)(lds + ML_OFF);
    float wa, wb = 0.f, inv;
    if (STAGE == 0) { wa = 1.0f; inv = 1.0f / ltot; }
    else { const f32x2 s = ml[row]; const float m2 = fmaxf(mrun, s.x); wa = __builtin_amdgcn_exp2f(mrun - m2); wb = s.y * __builtin_amdgcn_exp2f(s.x - m2);
        const float l2 = ltot * wa + wb; inv = 1.0f / l2; mrun = m2; lrun = l2; }
    if (STAGE == 0) lrun = ltot;
    wa *= inv; wb *= inv;
#pragma unroll
    for (int db = 0; db < 2; ++db)
#pragma unroll
        for (int rq = 0; rq < 4; ++rq) {
            const int ch8 = 8 * db + 2 * rq + hh;
            float v0 = (db ? o1[4 * rq + 0] : o0[4 * rq + 0]) * wa, v1 = (db ? o1[4 * rq + 1] : o0[4 * rq + 1]) * wa, v2 = (db ? o1[4 * rq + 2] : o0[4 * rq + 2]) * wa, v3 = (db ? o1[4 * rq + 3] : o0[4 * rq + 3]) * wa;
            if (STAGE != 0) { const u32x2 sv = *(const LAS u32x2*)(lds + st_addr(row, ch8));
                v0 += bf_lo(sv.x) * wb; v1 += bf_hi(sv.x) * wb; v2 += bf_lo(sv.y) * wb; v3 += bf_hi(sv.y) * wb; }
            u32x2 w; w.x = pk2(v0, v1); w.y = pk2(v2, v3);
            if (STAGE != 2) *(LAS u32x2*)(lds + st_addr(row, ch8)) = w;
            else *(u32x2*)(MIX + (rowb + tq) * D + 512 + h * 64 + 32 * db + 8 * rq + 4 * hh) = w;
        }
    if (STAGE != 2 && hh == 0) ml[row] = (f32x2){mrun, lrun};
}

__device__ __forceinline__ void att_sync() { asm volatile("s_waitcnt lgkmcnt(0)" ::: "memory"); __builtin_amdgcn_s_barrier(); asm volatile("" ::: "memory"); }
__device__ __forceinline__ void attn_unit(const Args& a, Frame& F, int bh, int sb, BgState& bg, int bg_stride) {
    const bf16_t* Q = (const bf16_t*)(a.ws + WS_Q); const bf16_t* K = (const bf16_t*)(a.ws + WS_K); const bf16_t* V = (const bf16_t*)(a.ws + WS_V);
    bf16_t* MIX = (bf16_t*)(a.ws + WS_MIX);
    const int b = bh >> 3, h = bh & 7, T0 = sb * 512;
    const int w2 = 2 * F.wave;
    const int t10 = T0 + (w2 >> 2) + 128 * (w2 & 3), t11 = T0 + ((w2 + 1) >> 2) + 128 * ((w2 + 1) & 3);
    wave_tile<0, 16>(a, bg, bg_stride, Q, K, V, MIX, b, h, T0, T0 + w2, F.lds, F.wave, F.lane);
    wave_tile<0, 16>(a, bg, bg_stride, Q, K, V, MIX, b, h, T0, T0 + w2 + 1, F.lds, F.wave, F.lane);
    att_sync();
    wave_tile<1, 4>(a, bg, bg_stride, Q, K, V, MIX, b, h, T0, t10, F.lds, F.wave, F.lane);
    wave_tile<1, 4>(a, bg, bg_stride, Q, K, V, MIX, b, h, T0, t11, F.lds, F.wave, F.lane);
    att_sync();
    wave_tile<2, 1>(a, bg, bg_stride, Q, K, V, MIX, b, h, T0, T0 + 32 * w2, F.lds, F.wave, F.lane);
    wave_tile<2, 1>(a, bg, bg_stride, Q, K, V, MIX, b, h, T0, T0 + 32 * (w2 + 1), F.lds, F.wave, F.lane);
    att_sync();
}
__device__ __forceinline__ void p4_attn(const Args& a, Frame& F) {
    const int lane = F.lane; const int bg_stride = 2 * F.G * 8;
    BgState bg; bg.itA = F.blk * 8 + F.wave; bg.itB = bg.itA + F.G * 8; bg.liveA = 0; bg.liveB = 0;
    bg_issue(a, bg.itA, lane, bg.tmpA); bg.itA += bg_stride; bg_issue(a, bg.itB, lane, bg.tmpB); bg.itB += bg_stride;
    LAS float* bg_scr = (LAS float*)(F.lds + BG_OFF + F.wave * 4224);
    for (int u = F.blk; u < 512; u += F.G) {
        const int blk = u & 255, i = u >> 8;
        const int x = blk & 7, j = blk >> 3, sb = j & 15, bh = x + 8 * ((j >> 4) + 2 * i);
        attn_unit(a, F, bh, sb, bg, bg_stride);
    }
#pragma unroll 1
    while (bg.itA - bg_stride < BG_ITEMS || bg.itB - bg_stride < BG_ITEMS) { BG_STEP(A); BG_STEP(B); }
}
}

__device__ __forceinline__ void p6_norm2_router_valu(const Args& a, Frame& F) {
    constexpr int WP = 1028;
    LAS float* wrT = (LAS float*)F.lds;
    LAS int* rec_e = (LAS int*)(F.lds + 32 * WP * 4);
    LAS int* rec_r = rec_e + 512;
    LAS float* rec_g = (LAS float*)(rec_r + 512);
    LAS int* lcount = (LAS int*)(rec_g + 512);
    LAS int* lbase = lcount + 32;
    const float* mod = (const float*)(a.ws + WS_MOD);
    unsigned char* H2 = a.ws + WS_H;
    gu32* gcnt = (gu32*)(a.ws + WS_CTL) + CW_GCNT;
    int* toklist = (int*)(a.ws + WS_TOKLIST);
    int* tokinfo = (int*)(a.ws + WS_TOKINFO);
    for (int i = F.tid; i < 1024 * 32; i += 512) { const int k = i >> 5, e = i & 31; wrT[e * WP + k] = a.w_router[i]; }
    for (int chunk = F.blk; chunk < T / 128; chunk += F.G) {
        if (F.tid < 32) lcount[F.tid] = 0;
        __syncthreads();
        const int tok0 = chunk * 128, b = tok0 / SEQ;
        f32x4 ga[4], sh[4];
#pragma unroll
        for (int j = 0; j < 4; ++j) { const int col = 4 * F.lane + 256 * j;
            const f32x4 g = *(const f32x4*)(a.g_ffn + col), sc = *(const f32x4*)(mod + b * 6144 + 4096 + col);
            ga[j] = g * (sc + 1.0f); sh[j] = *(const f32x4*)(mod + b * 6144 + 3072 + col); }
        const float brl = a.b_router[F.lane & 31];
#pragma unroll 1
        for (int tt = 0; tt < 16; ++tt) {
            const int tl = F.wave * 16 + tt, m = tok0 + tl;
            const f32x4* xr = (const f32x4*)(a.out + (size_t)m * D) + F.lane;
            f32x4 v[4]; float s = 0.f;
#pragma unroll
            for (int j = 0; j < 4; ++j) { v[j] = xr[64 * j]; s += (v[j].x * v[j].x + v[j].y * v[j].y) + (v[j].z * v[j].z + v[j].w * v[j].w); }
            const float rstd = 1.0f / sqrtf(wave_sum(s) * (1.0f / D) + NORM_EPS);
            unsigned* o4 = (unsigned*)(H2 + (size_t)m * D) + F.lane;
#pragma unroll
            for (int j = 0; j < 4; ++j) { v[j] = (v[j] * rstd) * ga[j] + sh[j]; o4[64 * j] = pk4_fp8(16.0f * v[j].x, 16.0f * v[j].y, 16.0f * v[j].z, 16.0f * v[j].w); }
            float mylogit = -3.0e38f;
#pragma unroll 4
            for (int e = 0; e < 32; ++e) { float p = 0.f;
#pragma unroll
                for (int j = 0; j < 4; ++j) { const f32x4 w = *(const LAS f32x4*)(wrT + e * WP + 4 * F.lane + 256 * j); p += (v[j].x * w.x + v[j].y * w.y) + (v[j].z * w.z + v[j].w * w.w); }
                p = wave_sum(p);
                if (F.lane == e) mylogit = p; }
            if (F.lane < 32) mylogit += brl;
            float tv0, tv1, tv2, tv3; int te0, te1, te2, te3;
#define TOPK_STEP(TV, TE) do { const float mx_ = wave_max(mylogit); const unsigned long long bal_ = __ballot(mylogit == mx_); const int sel_ = __ffsll((long long)bal_) - 1; \
                TV = mx_; TE = sel_; if (F.lane == sel_) mylogit = -3.0e38f; } while (0)
            TOPK_STEP(tv0, te0); TOPK_STEP(tv1, te1); TOPK_STEP(tv2, te2); TOPK_STEP(tv3, te3);
#undef TOPK_STEP
            const float e1 = __expf(tv1 - tv0), e2 = __expf(tv2 - tv0), e3 = __expf(tv3 - tv0); const float inv = 1.0f / (1.0f + e1 + e2 + e3);
            if (F.lane < 4) { int ee = te0; float gg = inv;
                if (F.lane == 1) { ee = te1; gg = e1 * inv; } if (F.lane == 2) { ee = te2; gg = e2 * inv; } if (F.lane == 3) { ee = te3; gg = e3 * inv; }
                const int lr = atomicAdd((int*)&lcount[ee], 1);
                rec_e[tl * 4 + F.lane] = ee; rec_r[tl * 4 + F.lane] = lr; rec_g[tl * 4 + F.lane] = gg; }
        }
        __syncthreads();
        if (F.tid < 32) lbase[F.tid] = (int)__hip_atomic_fetch_add(gcnt + 64 * F.tid, (unsigned)lcount[F.tid], __ATOMIC_RELAXED, __HIP_MEMORY_SCOPE_AGENT);
        __syncthreads();
        { const int tl = F.tid >> 2, k = F.tid & 3, e = rec_e[F.tid], rank = lbase[e] + rec_r[F.tid];
          toklist[(size_t)e * T + rank] = tok0 + tl;
          tokinfo[(size_t)(tok0 + tl) * 8 + 2 * k] = (e << 16) | rank; tokinfo[(size_t)(tok0 + tl) * 8 + 2 * k + 1] = __builtin_bit_cast(int, rec_g[F.tid]); }
        __syncthreads();
    }
}


template <bool DUMP> __device__ __forceinline__ void p6_norm2_router(const Args& a, Frame& F) {
    constexpr int HP = 1028;
    LAS float* ht = (LAS float*)F.lds;
    LAS int* rec_e = (LAS int*)(F.lds + 32 * HP * 4);
    LAS int* rec_r = rec_e + 512;
    LAS float* rec_g = (LAS float*)(rec_r + 512);
    LAS int* lcount = (LAS int*)(rec_g + 512);
    LAS int* lbase = lcount + 32;
    const float* mod = (const float*)(a.ws + WS_MOD);
    unsigned char* H2 = a.ws + (DUMP ? WS_ACT : WS_H);
    gu32* gcnt = (gu32*)(a.ws + WS_CTL) + CW_GCNT + (DUMP ? 4096 : 0);
    int* toklist = (int*)(a.ws + (DUMP ? WS_ACT + 64 * MiB : WS_TOKLIST));
    int* tokinfo = (int*)(a.ws + (DUMP ? WS_ACT + 80 * MiB : WS_TOKINFO));
    const int n = F.lane & 31, hk = F.lane >> 5;
    bf16x8 bhi[8], blo[8];
#pragma unroll
    for (int st = 0; st < 8; ++st) { const int k0 = 128 * F.wave + 16 * st + 8 * hk; u32x4 h4, l4;
#pragma unroll
        for (int jp = 0; jp < 4; ++jp) { const float w0 = a.w_router[(size_t)(k0 + 2 * jp) * 32 + n], w1 = a.w_router[(size_t)(k0 + 2 * jp + 1) * 32 + n];
            const unsigned hp = cvt_pk_bf16(w0, w1); h4[jp] = hp; l4[jp] = cvt_pk_bf16(w0 - bf_lo(hp), w1 - bf_hi(hp)); }
        bhi[st] = __builtin_bit_cast(bf16x8, h4); blo[st] = __builtin_bit_cast(bf16x8, l4); }
    const float brl = a.b_router[n];
    for (int chunk = F.blk; chunk < T / 128; chunk += F.G) {
        if (F.tid < 32) lcount[F.tid] = 0;
        const int tok0 = chunk * 128, b = tok0 / SEQ;
        f32x4 ga[4], sh[4];
#pragma unroll
        for (int j = 0; j < 4; ++j) { const int col = 4 * F.lane + 256 * j;
            const f32x4 g = *(const f32x4*)(a.g_ffn + col), sc = *(const f32x4*)(mod + b * 6144 + 4096 + col);
            ga[j] = g * (sc + 1.0f); sh[j] = *(const f32x4*)(mod + b * 6144 + 3072 + col); }
        f32x4 xv[4][4];
#define P6_LOAD(Q) do { _Pragma("unroll") for (int i = 0; i < 4; ++i) { const u32x2* xr = (const u32x2*)((const bf16_t*)(a.ws + WS_X1B) + (size_t)(tok0 + 32 * (Q) + 4 * F.wave + i) * D) + F.lane; \
            _Pragma("unroll") for (int j = 0; j < 4; ++j) { const u32x2 w_ = xr[64 * j]; xv[i][j] = (f32x4){bf_lo(w_.x), bf_hi(w_.x), bf_lo(w_.y), bf_hi(w_.y)}; } } } while (0)
        P6_LOAD(0);
#pragma unroll 1
        for (int q = 0; q < 4; ++q) {
#pragma unroll
            for (int i = 0; i < 4; ++i) { const int tl = 4 * F.wave + i, m = tok0 + 32 * q + tl;
                f32x4 v[4]; float s = 0.f;
#pragma unroll
                for (int j = 0; j < 4; ++j) { v[j] = xv[i][j]; s += (v[j].x * v[j].x + v[j].y * v[j].y) + (v[j].z * v[j].z + v[j].w * v[j].w); }
                const float rstd = 1.0f / sqrtf(wave_sum(s) * (1.0f / D) + NORM_EPS);
                unsigned* o4 = (unsigned*)(H2 + (size_t)m * D) + F.lane;
#pragma unroll
                for (int j = 0; j < 4; ++j) { v[j] = (v[j] * rstd) * ga[j] + sh[j]; o4[64 * j] = pk4_fp8(16.0f * v[j].x, 16.0f * v[j].y, 16.0f * v[j].z, 16.0f * v[j].w);
                    *(LAS f32x4*)(ht + tl * HP + 4 * F.lane + 256 * j) = v[j]; } }
            if (q < 3) P6_LOAD(q + 1);
            __syncthreads();
            f32x16 acc;
#pragma unroll
            for (int r = 0; r < 16; ++r) acc[r] = 0.f;
#pragma unroll
            for (int st = 0; st < 8; ++st) { const LAS float* ap = ht + n * HP + 128 * F.wave + 16 * st + 8 * hk;
                const f32x4 x0 = *(const LAS f32x4*)ap, x1 = *(const LAS f32x4*)(ap + 4);
                u32x4 h4, l4;
                h4.x = cvt_pk_bf16(x0.x, x0.y); h4.y = cvt_pk_bf16(x0.z, x0.w); h4.z = cvt_pk_bf16(x1.x, x1.y); h4.w = cvt_pk_bf16(x1.z, x1.w);
                l4.x = cvt_pk_bf16(x0.x - bf_lo(h4.x), x0.y - bf_hi(h4.x)); l4.y = cvt_pk_bf16(x0.z - bf_lo(h4.y), x0.w - bf_hi(h4.y));
                l4.z = cvt_pk_bf16(x1.x - bf_lo(h4.z), x1.y - bf_hi(h4.z)); l4.w = cvt_pk_bf16(x1.z - bf_lo(h4.w), x1.w - bf_hi(h4.w));
                const bf16x8 ahi = __builtin_bit_cast(bf16x8, h4), alo = __builtin_bit_cast(bf16x8, l4);
                acc = __builtin_amdgcn_mfma_f32_32x32x16_bf16(ahi, bhi[st], acc, 0, 0, 0);
                acc = __builtin_amdgcn_mfma_f32_32x32x16_bf16(alo, bhi[st], acc, 0, 0, 0);
                acc = __builtin_amdgcn_mfma_f32_32x32x16_bf16(ahi, blo[st], acc, 0, 0, 0); }
            __syncthreads();
#pragma unroll
            for (int r = 0; r < 16; ++r) { const int tk = (r & 3) + 8 * (r >> 2) + 4 * hk; ht[F.wave * 1024 + tk * 32 + n] = acc[r]; }
            __syncthreads();
            { LAS float* L = ht + 8192;
#pragma unroll
              for (int rep = 0; rep < 2; ++rep) { const int o = F.tid + 512 * rep; float sacc = brl;
#pragma unroll
                  for (int w = 0; w < 8; ++w) sacc += ht[w * 1024 + o];
                  L[(o >> 5) * 33 + (o & 31)] = sacc; }
              __syncthreads();
              if (F.wave == 0 && F.lane < 32) { const int tl = 32 * q + F.lane;
                  float lv[32];
#pragma unroll
                  for (int e = 0; e < 32; ++e) lv[e] = L[F.lane * 33 + e];
                  float tv[4]; int te[4];
#pragma unroll
                  for (int k = 0; k < 4; ++k) { float best = lv[0]; int bi = 0;
#pragma unroll
                      for (int e = 1; e < 32; ++e) { const bool gt = lv[e] > best; best = gt ? lv[e] : best; bi = gt ? e : bi; }
                      tv[k] = best; te[k] = bi;
#pragma unroll
                      for (int e = 0; e < 32; ++e) lv[e] = (e == bi) ? -3.0e38f : lv[e]; }
                  const float e1 = __expf(tv[1] - tv[0]), e2 = __expf(tv[2] - tv[0]), e3 = __expf(tv[3] - tv[0]); const float inv = 1.0f / (1.0f + e1 + e2 + e3);
                  const float gk[4] = {inv, e1 * inv, e2 * inv, e3 * inv};
#pragma unroll
                  for (int k = 0; k < 4; ++k) { const int lr = atomicAdd((int*)&lcount[te[k]], 1); rec_e[tl * 4 + k] = te[k]; rec_r[tl * 4 + k] = lr; rec_g[tl * 4 + k] = gk[k]; } } }
            __syncthreads();
        }
#undef P6_LOAD
        if (F.tid < 32) lbase[F.tid] = (int)__hip_atomic_fetch_add(gcnt + 64 * F.tid, (unsigned)lcount[F.tid], __ATOMIC_RELAXED, __HIP_MEMORY_SCOPE_AGENT);
        __syncthreads();
        { const int tl = F.tid >> 2, k = F.tid & 3, e = rec_e[F.tid], rank = lbase[e] + rec_r[F.tid];
          toklist[(size_t)e * T + rank] = tok0 + tl;
          tokinfo[(size_t)(tok0 + tl) * 8 + 2 * k] = (e << 16) | rank; tokinfo[(size_t)(tok0 + tl) * 8 + 2 * k + 1] = __builtin_bit_cast(int, rec_g[F.tid]); }
        __syncthreads();
    }
}

__device__ __forceinline__ int moe_tables(const Args& a, Frame& F) {
    LAS int* tile_e = (LAS int*)(F.lds + L_TILE_E); LAS int* tstart = (LAS int*)(F.lds + L_TSTART); LAS int* cnt = (LAS int*)(F.lds + L_CNT);
    const unsigned* gcnt = (const unsigned*)(a.ws + WS_CTL) + CW_GCNT;
    if (F.tid < 64) {
        const int c = F.tid < 32 ? (int)gcnt[64 * F.tid] : 0; const int nt = (c + 255) >> 8;
        int inc = nt;
#pragma unroll
        for (int o = 1; o < 32; o <<= 1) { const int v = __shfl_up(inc, o); if ((F.tid & 63) >= o) inc += v; }
        if (F.tid < 32) { cnt[F.tid] = c; tstart[F.tid] = inc - nt; }
        if (F.tid == 31) tstart[32] = inc;
    }
    __syncthreads();
    const int RT = tstart[32];
    for (int g = F.tid; g < RT; g += 512) { int e = 0; for (int q = 1; q < 32; ++q) e = (g >= tstart[q]) ? q : e; tile_e[g] = e; }
    __syncthreads();
    return RT;
}

template <bool DUMP> __device__ __forceinline__ void p9_combine(const Args& a, Frame& F) {
    if (N_LAUNCH_MODE == 1) (void)moe_tables(a, F);
    const LAS int* tstart = (const LAS int*)(F.lds + L_TSTART);
    const float* mod = (const float*)(a.ws + WS_MOD);
    const unsigned char* Y = a.ws + WS_Y;
    const int* tokinfo = (const int*)(a.ws + WS_TOKINFO);
    const int gw = F.blk * 8 + F.wave, NGW = F.G * 8;
    f32x4 gfv[4];
#pragma unroll
    for (int j = 0; j < 4; ++j) gfv[j] = *(const f32x4*)(a.g_final + 4 * F.lane + 256 * j);
    int inf = (F.lane < 16 && 2 * gw < T) ? tokinfo[(size_t)(2 * gw) * 8 + F.lane] : 0;
#pragma unroll 1
    for (int m = 2 * gw; m < T; m += 2 * NGW) {
        const int b = m / SEQ;
        const int cur = inf;
        { const int mn = m + 2 * NGW; inf = (F.lane < 16 && mn < T) ? tokinfo[(size_t)mn * 8 + F.lane] : 0; }
        f32x4 v[2][4]; unsigned yv[2][4][4]; float gate[2][4];
        f32x4 g2v[4];
#pragma unroll
        for (int j = 0; j < 4; ++j) g2v[j] = *(const f32x4*)(mod + b * 6144 + 5120 + 4 * F.lane + 256 * j);
#pragma unroll
        for (int t = 0; t < 2; ++t) {
            const u32x2* xr = (const u32x2*)((const bf16_t*)(a.ws + WS_X1B) + (size_t)(m + t) * D) + F.lane;
#pragma unroll
            for (int j = 0; j < 4; ++j) { const u32x2 w_ = xr[64 * j]; v[t][j] = (f32x4){bf_lo(w_.x), bf_hi(w_.x), bf_lo(w_.y), bf_hi(w_.y)}; }
#pragma unroll
            for (int k = 0; k < 4; ++k) { const int er = __builtin_amdgcn_readlane(cur, 8 * t + 2 * k); gate[t][k] = __builtin_bit_cast(float, __builtin_amdgcn_readlane(cur, 8 * t + 2 * k + 1)) * 0.0625f;
                const int e = er >> 16, rank = er & 0xffff; const size_t slot = (size_t)tstart[e] * 256 + rank;
                const unsigned* yr = (const unsigned*)(Y + slot * D) + F.lane;
#pragma unroll
                for (int j = 0; j < 4; ++j) yv[t][k][j] = yr[64 * j]; }
        }
#pragma unroll
        for (int t = 0; t < 2; ++t) {
            f32x4 acc[4];
#pragma unroll
            for (int j = 0; j < 4; ++j) acc[j] = (f32x4){0.f, 0.f, 0.f, 0.f};
#pragma unroll
            for (int k = 0; k < 4; ++k)
#pragma unroll
                for (int j = 0; j < 4; ++j) { const unsigned w = yv[t][k][j]; const float g = gate[t][k]; const f32x2 lo = __builtin_amdgcn_cvt_pk_f32_fp8(w, false), hi = __builtin_amdgcn_cvt_pk_f32_fp8(w, true);
                    acc[j].x += g * lo.x; acc[j].y += g * lo.y; acc[j].z += g * hi.x; acc[j].w += g * hi.y; }
            float s = 0.f;
#pragma unroll
            for (int j = 0; j < 4; ++j) { v[t][j] = v[t][j] + g2v[j] * acc[j];
                s += (v[t][j].x * v[t][j].x + v[t][j].y * v[t][j].y) + (v[t][j].z * v[t][j].z + v[t][j].w * v[t][j].w); }
            const float rstd = 1.0f / sqrtf(wave_sum(s) * (1.0f / D) + NORM_EPS);
            f32x4* xo = (f32x4*)((DUMP ? (float*)(a.ws + WS_ACT) : a.out) + (size_t)(m + t) * D) + F.lane;
#pragma unroll
            for (int j = 0; j < 4; ++j) xo[64 * j] = v[t][j] * rstd * gfv[j];
        }
    }
}

__global__ void __launch_bounds__(512, 2) fwd_kernel(Args args) {
    extern __shared__ __attribute__((aligned(16))) unsigned char lds_raw[];
    Frame F; F.lds = (LAS unsigned char*)lds_raw; F.tid = threadIdx.x; F.lane = F.tid & 63; F.wave = __builtin_amdgcn_readfirstlane(F.tid >> 6); F.G = gridDim.x; F.blk = blockIdx.x;
    volatile LAS unsigned* misc = (volatile LAS unsigned*)(F.lds + L_MISC);
    if (F.tid < 4) misc[F.tid] = 0u;
    __syncthreads();
    const int lo = args.ph_lo, hi = args.ph_hi;
    unsigned* barw = (unsigned*)(args.ws + WS_CTL) + CW_BAR;
    XcdBarrier bar; bar.bar = barw; bar.x = 0; bar.st = misc;
    if (hi - lo > 1) bar = xcd_barrier_post(barw, misc);
#ifndef PH_MASK
#define PH_MASK 0x3ff
#endif
#define IN(k) (((PH_MASK >> (k)) & 1) && lo <= (k) && (k) < hi)
#ifndef DUP_MASK
#define DUP_MASK 0
#endif
#define DUP(k) (((DUP_MASK >> (k)) & 1) ? 2 : 1)
#define SEAM(k) do { if (IN(k) && IN((k) + 1)) xcd_barrier(bar); } while (0)
    unsigned char* ws = args.ws;

    if (IN(0)) { for (int r_ = 0; r_ < DUP(0); ++r_) { if (r_) xcd_barrier(bar); p0_prologue(args, F); } } SEAM(0);
    if (IN(1)) { for (int r_ = 0; r_ < DUP(1); ++r_) { if (r_) xcd_barrier(bar); p1_norm1(args, F); } } SEAM(1);
    if (IN(2)) for (int r_ = 0; r_ < DUP(2); ++r_) {
        if (r_) xcd_barrier(bar);
        pg8::PlainSched S; S.init(T, INC, F.G, F.blk, ws + WS_H, ws + WS_WIN);
#if FUSE_SPLIT
        static_assert(WS_K - WS_Q == WS_V - WS_K, "q | k | v equally spaced");
        pg8::EpiIn E{(bf16_t*)(ws + WS_U), (bf16_t*)(ws + WS_Q), (const float*)(ws + WS_ROPE)};
        pg8::gemm_phase<pg8::EpiIn, pg8::PlainSched, true>(F.lds, S, E);
#else
        pg8::EpiProj E{(bf16_t*)(ws + WS_PROJ)};
        pg8::gemm_phase<pg8::EpiProj, pg8::PlainSched, true>(F.lds, S, E);
#endif
    } SEAM(2);
#if !FUSE_SPLIT
    if (IN(3)) { for (int r_ = 0; r_ < DUP(3); ++r_) { if (r_) xcd_barrier(bar); p3_split(args, F); } } SEAM(3);
#endif
    if (IN(4)) { if (P4_PARTS & 1) p4_conv(args, F); if (P4_PARTS & 2) att::p4_attn(args, F);
#if (DUP_MASK >> 4) & 1
        xcd_barrier(bar); if (DUP4_PARTS & 1) p4_conv(args, F); if (DUP4_PARTS & 2) att::p4_attn(args, F);
#endif
    } SEAM(4);
    if (IN(5)) for (int r_ = 0; r_ < DUP(5); ++r_) {
        if (r_) xcd_barrier(bar);
        pg8::PlainSched S; S.init(T, D, F.G, F.blk, ws + WS_MIX, ws + WS_WOUT);
        pg8::EpiOut E{args.x, (bf16_t*)(ws + WS_X1B), (const float*)(ws + WS_MOD)};
        pg8::gemm_phase<pg8::EpiOut, pg8::PlainSched, true>(F.lds, S, E);
    } SEAM(5);
    if (IN(6)) {
#if (DUP_MASK >> 6) & 1
        p6_norm2_router<true>(args, F); xcd_barrier(bar);
#endif
        if (ROUTER_MFMA) p6_norm2_router<false>(args, F); else p6_norm2_router_valu(args, F); } SEAM(6);
    if (IN(7)) for (int r_ = 0; r_ < DUP(7); ++r_) {
        if (r_) xcd_barrier(bar);
        const int RT = moe_tables(args, F);
        pg8::MoeSched<true> S; S.nN = 8; S.nunits = RT * 8; S.G = F.G; S.c = F.blk; S.A = (const char*)(ws + WS_H); S.Bt = (const char*)(ws + WS_WGU); S.estride = (size_t)2048 * 1024;
        S.tile_e = (const LAS int*)(F.lds + L_TILE_E); S.rowtab = (const LAS unsigned*)(F.lds + L_ROWTAB);
        { LAS unsigned* rowtab = (LAS unsigned*)(F.lds + L_ROWTAB); const LAS int* tstart = (const LAS int*)(F.lds + L_TSTART); const LAS int* cnt = (const LAS int*)(F.lds + L_CNT);
          const int* toklist = (const int*)(ws + WS_TOKLIST); pg8::Unit u;
          unsigned vals[9];
#pragma unroll
          for (int j = 0; j < 9; ++j) { const int i = 2 * j + (F.tid >> 8); vals[j] = 0u;
              if (i < 17 && S.next(i, u)) { const int idx = (u.pm - tstart[u.e]) * 256 + (F.tid & 255); if (idx < cnt[u.e]) vals[j] = (unsigned)toklist[(size_t)u.e * T + idx] * 1024u; } }
#pragma unroll
          for (int j = 0; j < 9; ++j) { const int i = 2 * j + (F.tid >> 8); if (i < 17) rowtab[i * 256 + (F.tid & 255)] = vals[j]; }
          __syncthreads(); }
        pg8::EpiSwiglu E{ws + WS_ACT, args.b_gu};
        pg8::gemm_phase<pg8::EpiSwiglu, pg8::MoeSched<true>, true>(F.lds, S, E);
    } SEAM(7);
    if (IN(8)) for (int r_ = 0; r_ < DUP(8); ++r_) {
        if (r_) xcd_barrier(bar);
        const int RT = (N_LAUNCH_MODE == 1) ? moe_tables(args, F) : ((const LAS int*)(F.lds + L_TSTART))[32];
        pg8::MoeSched<false> S; S.nN = 4; S.nunits = RT * 4; S.G = F.G; S.c = F.blk; S.A = (const char*)(ws + WS_ACT); S.Bt = (const char*)(ws + WS_WDOWN); S.estride = (size_t)1024 * 1024;
        S.tile_e = (const LAS int*)(F.lds + L_TILE_E); S.rowtab = nullptr;
        pg8::EpiDown E{ws + WS_Y, args.b_down};
        pg8::gemm_phase<pg8::EpiDown, pg8::MoeSched<false>, true>(F.lds, S, E);
    } SEAM(8);
    if (IN(9)) {
#if (DUP_MASK >> 9) & 1
        p9_combine<true>(args, F); xcd_barrier(bar);
#endif
        p9_combine<false>(args, F); }
#undef IN
#undef SEAM
}

extern "C" void kernel_launch(void* const* d_in, const int* in_sizes, int n_in, void* d_out, int out_size, void* d_ws, size_t ws_size, hipStream_t stream) {
    static int grid = 0;
    if (grid == 0) {
        if (n_in != 20 || in_sizes[0] != T * D || out_size != T * D || ws_size < WS_END) { fprintf(stderr, "kernel_launch: unexpected shapes (n_in %d, in0 %d, out %d, ws %zu)\n", n_in, n_in > 0 ? in_sizes[0] : -1, out_size, ws_size); grid = -1; return; }
        int dev = 0, cus = 0, per_cu = 0;
        if (hipGetDevice(&dev) != hipSuccess || hipDeviceGetAttribute(&cus, hipDeviceAttributeMultiprocessorCount, dev) != hipSuccess) { grid = -1; return; }
        if (hipFuncSetAttribute((const void*)fwd_kernel, hipFuncAttributeMaxDynamicSharedMemorySize, LDS_BYTES) != hipSuccess) { fprintf(stderr, "kernel_launch: hipFuncSetAttribute failed\n"); grid = -1; return; }
        if (hipOccupancyMaxActiveBlocksPerMultiprocessor(&per_cu, (const void*)fwd_kernel, 512, LDS_BYTES) != hipSuccess || per_cu < 1) { fprintf(stderr, "kernel_launch: occupancy query says %d\n", per_cu); }
        (void)hipGetLastError();
        grid = cus;
    }
    if (grid < 0) return;
    (void)hipMemsetAsync((char*)d_ws + WS_CTL + (size_t)CW_BAR * 4, 0, (size_t)(CW_GCNT + 64 * 32 - CW_BAR) * 4, stream);
    Args a{};
    a.x = (const float*)d_in[0]; a.c = (const float*)d_in[1]; a.pos = (const int*)d_in[2]; a.w_ada = (const float*)d_in[3]; a.b_ada = (const float*)d_in[4]; a.g_mix = (const float*)d_in[5];
    a.w_in = (const float*)d_in[6]; a.conv_w = (const float*)d_in[7]; a.conv_b = (const float*)d_in[8]; a.ln_g = (const float*)d_in[9]; a.ln_b = (const float*)d_in[10]; a.w_out = (const float*)d_in[11];
    a.g_ffn = (const float*)d_in[12]; a.w_router = (const float*)d_in[13]; a.b_router = (const float*)d_in[14]; a.w_gu = (const float*)d_in[15]; a.b_gu = (const float*)d_in[16];
    a.w_down = (const float*)d_in[17]; a.b_down = (const float*)d_in[18]; a.g_final = (const float*)d_in[19];
    a.out = (float*)d_out; a.ws = (unsigned char*)d_ws;
#if N_LAUNCH_MODE == 1
    for (int p = 0; p < NPHASE; ++p) { a.ph_lo = p; a.ph_hi = p + 1; hipLaunchKernelGGL(fwd_kernel, dim3(grid), dim3(512), LDS_BYTES, stream, a); }
#else
    a.ph_lo = 0; a.ph_hi = NPHASE; hipLaunchKernelGGL(fwd_kernel, dim3(grid), dim3(512), LDS_BYTES, stream, a);
#endif
}
```

```cpp
#include <hip/hip_runtime.h>
#include <cstdio>
#include <cstdint>

#define LAS __attribute__((address_space(3)))
#define GAS __attribute__((address_space(1)))
typedef unsigned short bf16_t;
typedef short bf16x8 __attribute__((ext_vector_type(8)));
typedef short s16x4 __attribute__((ext_vector_type(4)));
typedef float f32x2 __attribute__((ext_vector_type(2)));
typedef float f32x4 __attribute__((ext_vector_type(4)));
typedef float f32x16 __attribute__((ext_vector_type(16)));
typedef unsigned u32x2 __attribute__((ext_vector_type(2)));
typedef unsigned u32x4 __attribute__((ext_vector_type(4)));
typedef GAS unsigned gu32;
typedef int v4i __attribute__((ext_vector_type(4)));
typedef int v8i __attribute__((ext_vector_type(8)));

#ifndef DUP4_PARTS
#define DUP4_PARTS 3
#endif
#ifndef P4_PARTS
#define P4_PARTS 3
#endif
#ifndef BG_IN_ATTN
#define BG_IN_ATTN 1
#endif
#ifndef FUSE_SPLIT
#define FUSE_SPLIT 1
#endif
#ifndef ROUTER_MFMA
#define ROUTER_MFMA 1
#endif
#ifndef N_LAUNCH_MODE
#define N_LAUNCH_MODE 0
#endif

constexpr int NB = 4, SEQ = 8192, T = NB * SEQ, D = 1024, NE = 32, INC = 2560, NH = 8;
constexpr int NPHASE = 10;
constexpr float NORM_EPS = 1e-6f;

constexpr size_t MiB = 1u << 20;
constexpr size_t WS_CTL = 0, CTL_ZERO_BYTES = 1 * MiB;
constexpr size_t WS_MOD = 1 * MiB;
constexpr size_t WS_ROPE = 2 * MiB;
constexpr size_t WS_TOKINFO = 4 * MiB;
constexpr size_t WS_TOKLIST = 6 * MiB;
constexpr size_t WS_WIN = 10 * MiB;
constexpr size_t WS_WOUT = 16 * MiB;
constexpr size_t WS_WDOWN = 32 * MiB;
constexpr size_t WS_WGU = 96 * MiB;
constexpr size_t WS_H = 224 * MiB;
constexpr size_t WS_PROJ = 288 * MiB;
constexpr size_t WS_U = 448 * MiB;
constexpr size_t WS_Q = 480 * MiB, WS_K = 512 * MiB, WS_V = 544 * MiB;
constexpr size_t WS_MIX = 576 * MiB;
constexpr size_t WS_ACT = 640 * MiB;
constexpr size_t WS_Y = 288 * MiB;
constexpr size_t WS_X1B = 448 * MiB;
constexpr size_t WS_END = 912 * MiB;
constexpr int MAX_RT = 544;

constexpr int CW_BAR = 4096;
constexpr int CW_GCNT = 16384;

constexpr int LDS_BYTES = 155648;
constexpr int L_ROWTAB = 131072;
constexpr int L_TILE_E = 148480;
constexpr int L_TSTART = 150784;
constexpr int L_CNT = 151040;
constexpr int L_MISC = 155392;

__device__ __forceinline__ unsigned f2bf(float f) { unsigned u = __builtin_bit_cast(unsigned, f); return (u + 0x7fffu + ((u >> 16) & 1u)) >> 16; }
__device__ __forceinline__ unsigned pk2(float lo, float hi) { return f2bf(lo) | (f2bf(hi) << 16); }
__device__ __forceinline__ unsigned cvt_pk_bf16(float lo, float hi) { unsigned r; asm("v_cvt_pk_bf16_f32 %0, %1, %2" : "=v"(r) : "v"(lo), "v"(hi)); return r; }
__device__ __forceinline__ unsigned pk4_fp8(float a, float b, float c, float d) { unsigned w = 0; w = __builtin_amdgcn_cvt_pk_fp8_f32(a, b, w, false); w = __builtin_amdgcn_cvt_pk_fp8_f32(c, d, w, true); return w; }
__device__ __forceinline__ float bf_lo(unsigned u) { return __builtin_bit_cast(float, u << 16); }
__device__ __forceinline__ float bf_hi(unsigned u) { return __builtin_bit_cast(float, u & 0xffff0000u); }
__device__ __forceinline__ float wave_sum(float v) {
    int x = __builtin_bit_cast(int, v);
    v += __builtin_bit_cast(float, __builtin_amdgcn_update_dpp(0, x, 0xB1, 0xF, 0xF, false)); x = __builtin_bit_cast(int, v);
    v += __builtin_bit_cast(float, __builtin_amdgcn_update_dpp(0, x, 0x4E, 0xF, 0xF, false)); x = __builtin_bit_cast(int, v);
    v += __builtin_bit_cast(float, __builtin_amdgcn_update_dpp(0, x, 0x141, 0xF, 0xF, false)); x = __builtin_bit_cast(int, v);
    v += __builtin_bit_cast(float, __builtin_amdgcn_update_dpp(0, x, 0x140, 0xF, 0xF, false)); x = __builtin_bit_cast(int, v);
    const float r0 = __builtin_bit_cast(float, __builtin_amdgcn_readlane(x, 0)), r1 = __builtin_bit_cast(float, __builtin_amdgcn_readlane(x, 16));
    const float r2 = __builtin_bit_cast(float, __builtin_amdgcn_readlane(x, 32)), r3 = __builtin_bit_cast(float, __builtin_amdgcn_readlane(x, 48));
    return (r0 + r1) + (r2 + r3);
}
__device__ __forceinline__ float wave_max(float v) {
#pragma unroll
    for (int o = 1; o < 64; o <<= 1) v = fmaxf(v, __shfl_xor(v, o));
    return v;
}
__device__ __forceinline__ float fast_sigmoid(float x) { return __builtin_amdgcn_rcpf(1.0f + __builtin_amdgcn_exp2f(-1.4426950408889634f * x)); }

namespace pg8 {
constexpr int BM = 256, BK = 64, HALF = 128, HTB = HALF * BK * 2, STAGE_BYTES = 8 * HTB, NXCD = 8, WGM = 8;
constexpr int KD = 1024;

__host__ __device__ __forceinline__ int lds_byte(int r, int c) { const int st = (r >> 4) * 2 + (c >> 5), rr = r & 15, cc = c & 31, ob = rr * 64 + cc * 2; return st * 1024 + (ob ^ (((ob >> 9) & 1) << 5)); }
__host__ __device__ __forceinline__ void stage_rc(int b, int& R, int& C) { const int st = b / 1024, sb = b % 1024, swz = sb ^ (((sb >> 9) & 1) << 5); R = (st >> 1) * 16 + swz / 64; C = (st & 1) * 32 + (swz % 64) / 2; }
__host__ __device__ __forceinline__ int perm32(int rho) { const int n = rho >> 4, i = rho & 15; return 8 * (i >> 2) + 4 * n + (i & 3); }

struct Unit { int pm, pn, e, slot; };

template <class Epi, class Sched, bool ALIGN_EPI>
__device__ __forceinline__ void gemm_phase(LAS unsigned char* lds, const Sched& S, const Epi& E) {
    int tid_ = threadIdx.x; asm volatile("" : "+v"(tid_));
    const int tid = tid_, wid = __builtin_amdgcn_readfirstlane(tid >> 6), lane = tid & 63, wr = wid >> 2, wc = wid & 3, fr = lane & 15, fq = lane >> 4;
    constexpr bool FP8 = Sched::FP8; constexpr int PITCH = FP8 ? KD : KD * 2, nt = PITCH / 128;
    unsigned voffB[2];
#pragma unroll
    for (int i = 0; i < 2; ++i) { int R, C; stage_rc(tid * 16 + i * 8192, R, C); const int Rb = Epi::PERM ? ((R & ~31) + perm32(R & 31)) : R;
        voffB[i] = (unsigned)(Rb * PITCH + C * 2); }
#define PG8_AVOFF(U, V) do { int tid2_ = threadIdx.x; asm volatile("" : "+v"(tid2_)); int Rr[2], Cc[2]; _Pragma("unroll") for (int i = 0; i < 2; ++i) { int R, C; stage_rc(tid2_ * 16 + i * 8192, R, C); Rr[i] = R; Cc[i] = C * 2; } S.a_voff(U, Rr, Cc, V); } while (0)
    constexpr size_t kstep = (size_t)(BK * 2);
    constexpr size_t hstep = (size_t)HALF * PITCH;
    const unsigned ldsw = (unsigned)wid * 1024u;
    const int aoff = lds_byte(wr * 64 + fr, fq * 8), boff = lds_byte(wc * 32 + fr, fq * 8);
#define PG8_SA(b, h) (((b) * 2 + (h)) * HTB)
#define PG8_SB(b, h) ((4 + (b) * 2 + (h)) * HTB)
#define PG8_STAGE(bufoff, gbase, voff) do { _Pragma("unroll") for (int _i = 0; _i < 2; ++_i) \
        __builtin_amdgcn_global_load_lds((const unsigned*)((const char*)(gbase) + (voff)[_i]), (LAS unsigned*)(lds + (bufoff) + ldsw + _i * 8192), 16, 0, 0); } while (0)
#define PG8_LDA(dst, b, h) do { if constexpr (FP8) { _Pragma("unroll") for (int m = 0; m < 4; ++m) { const v4i lo_ = *(const LAS v4i*)(lds + PG8_SA(b, h) + aoff + m * 2048), hi_ = *(const LAS v4i*)(lds + PG8_SA(b, h) + aoff + m * 2048 + 1024); \
            dst##8[m] = __builtin_shufflevector(lo_, hi_, 0, 1, 2, 3, 4, 5, 6, 7); } } \
        else { _Pragma("unroll") for (int m = 0; m < 4; ++m) _Pragma("unroll") for (int k = 0; k < 2; ++k) dst[m][k] = *(const LAS bf16x8*)(lds + PG8_SA(b, h) + aoff + m * 2048 + k * 1024); } } while (0)
#define PG8_LDB(dst, b, h) do { if constexpr (FP8) { _Pragma("unroll") for (int n = 0; n < 2; ++n) { const v4i lo_ = *(const LAS v4i*)(lds + PG8_SB(b, h) + boff + n * 2048), hi_ = *(const LAS v4i*)(lds + PG8_SB(b, h) + boff + n * 2048 + 1024); \
            dst##8[n] = __builtin_shufflevector(lo_, hi_, 0, 1, 2, 3, 4, 5, 6, 7); } } \
        else { _Pragma("unroll") for (int n = 0; n < 2; ++n) _Pragma("unroll") for (int k = 0; k < 2; ++k) dst[n][k] = *(const LAS bf16x8*)(lds + PG8_SB(b, h) + boff + n * 2048 + k * 1024); } } while (0)
#define PG8_MMA(ai, bj, At, Bt) do { __builtin_amdgcn_s_setprio(1); _Pragma("unroll") for (int m = 0; m < 4; ++m) _Pragma("unroll") for (int n = 0; n < 2; ++n) { \
        if constexpr (FP8) asm volatile("v_mfma_scale_f32_16x16x128_f8f6f4 %0, %1, %2, %0, %3, %4 op_sel_hi:[0,0,0]" : "+v"(acc[ai][bj][m][n]) : "v"(Bt##8[n]), "v"(At##8[m]), "v"((bj) ? sc_w1 : sc_w), "v"(sc_a)); \
        else { _Pragma("unroll") for (int k = 0; k < 2; ++k) acc[ai][bj][m][n] = __builtin_amdgcn_mfma_f32_16x16x32_bf16(Bt[n][k], At[m][k], acc[ai][bj][m][n], 0, 0, 0); } } \
        __builtin_amdgcn_s_setprio(0); } while (0)
#define PG8_WAIT_V(n) asm volatile("s_waitcnt vmcnt(" #n ")" ::: "memory")
#define PG8_WAIT_L(n) asm volatile("s_waitcnt lgkmcnt(" #n ")" ::: "memory")
#define PG8_BAR __builtin_amdgcn_s_barrier()
#define PG8_SCHED __builtin_amdgcn_sched_barrier(0)
    Unit cur, nxt; int ui = 0;
    if (!S.next(0, cur)) return;
    f32x4 acc[2][2][4][2];
    typename Epi::Pre pre_n;
    { typename Epi::Pre pre_c; E.fetch_sync(pre_c, cur, wr, wc, fr, fq); E.init(acc, pre_c); }
    const int sc_w = Sched::SCALE_W, sc_w1 = Sched::SCALE_W1, sc_a = Sched::SCALE_A;
    bf16x8 At[4][2], B0[2][2], B1[2][2]; v8i At8[4], B08[2], B18[2];
    unsigned cAv[2][2], nAv[2][2];
    PG8_AVOFF(cur, cAv);
    const char* const Abase = S.a_base();
    const char* cB = S.b_tile(cur);
    PG8_STAGE(PG8_SB(0, 0), cB, voffB); PG8_STAGE(PG8_SB(0, 1), cB + hstep, voffB); PG8_STAGE(PG8_SA(0, 0), Abase, cAv[0]); PG8_STAGE(PG8_SA(0, 1), Abase, cAv[1]);
    if (wr == 1) PG8_BAR;
    PG8_WAIT_V(2); PG8_BAR;
    PG8_STAGE(PG8_SB(1, 0), cB + kstep, voffB); PG8_STAGE(PG8_SA(1, 0), Abase + kstep, cAv[0]); PG8_STAGE(PG8_SB(1, 1), cB + hstep + kstep, voffB);
    PG8_WAIT_V(6); PG8_BAR;
    for (;;) {
        const bool has_next = S.next(ui + 1, nxt);
        unsigned rAv[2][2];
        if (has_next) PG8_AVOFF(nxt, rAv); else { rAv[0][0] = cAv[0][0]; rAv[0][1] = cAv[0][1]; rAv[1][0] = cAv[1][0]; rAv[1][1] = cAv[1][1]; }
        const char* rB = has_next ? S.b_tile(nxt) : cB;
#ifdef DUP_K
#pragma unroll 1
      for (int rep_ = 0; rep_ < 2; ++rep_) {
        const char* nB = rep_ ? rB : cB;
        nAv[0][0] = rep_ ? rAv[0][0] : cAv[0][0]; nAv[0][1] = rep_ ? rAv[0][1] : cAv[0][1]; nAv[1][0] = rep_ ? rAv[1][0] : cAv[1][0]; nAv[1][1] = rep_ ? rAv[1][1] : cAv[1][1];
        if (rep_) { _Pragma("unroll") for (int a_ = 0; a_ < 2; ++a_) _Pragma("unroll") for (int b_ = 0; b_ < 2; ++b_) _Pragma("unroll") for (int m_ = 0; m_ < 4; ++m_) _Pragma("unroll") for (int n_ = 0; n_ < 2; ++n_) asm volatile("" :: "v"(acc[a_][b_][m_][n_]));
            typename Epi::Pre pre_r; E.fetch_sync(pre_r, cur, wr, wc, fr, fq); E.init(acc, pre_r); }
#else
        { const char* nB = rB; nAv[0][0] = rAv[0][0]; nAv[0][1] = rAv[0][1]; nAv[1][0] = rAv[1][0]; nAv[1][1] = rAv[1][1];
#endif
#pragma unroll 1
        for (int t = 0; t < nt; t += 2) {
            const bool last = (t == nt - 2);
            const char* a1 = Abase + (size_t)(t + 1) * kstep;
            const char* a2 = last ? Abase : Abase + (size_t)(t + 2) * kstep; const char* b2 = last ? nB : cB + (size_t)(t + 2) * kstep;
            const char* a3 = a2 + kstep; const char* b3 = b2 + kstep;
            unsigned a2v0[2], a2v1[2];
            a2v0[0] = last ? nAv[0][0] : cAv[0][0]; a2v0[1] = last ? nAv[0][1] : cAv[0][1];
            a2v1[0] = last ? nAv[1][0] : cAv[1][0]; a2v1[1] = last ? nAv[1][1] : cAv[1][1];
            PG8_LDB(B0, 0, 0); PG8_LDB(B1, 0, 1); PG8_SCHED; PG8_LDA(At, 0, 0); PG8_STAGE(PG8_SA(1, 1), a1, cAv[1]);
            PG8_WAIT_V(8); PG8_WAIT_L(0); PG8_BAR; PG8_MMA(0, 0, At, B0); PG8_MMA(0, 1, At, B1); PG8_BAR; PG8_SCHED;
            PG8_LDA(At, 0, 1); PG8_STAGE(PG8_SB(0, 0), b2, voffB); PG8_STAGE(PG8_SB(0, 1), b2 + hstep, voffB); PG8_STAGE(PG8_SA(0, 0), a2, a2v0);
            PG8_WAIT_V(8); PG8_WAIT_L(0); PG8_BAR; PG8_MMA(1, 0, At, B0); PG8_MMA(1, 1, At, B1); PG8_BAR; PG8_SCHED;
            PG8_LDB(B0, 1, 0); PG8_LDB(B1, 1, 1); PG8_SCHED; PG8_LDA(At, 1, 0); PG8_STAGE(PG8_SA(0, 1), a2, a2v1);
            PG8_WAIT_V(8); PG8_WAIT_L(0); PG8_BAR; PG8_MMA(0, 0, At, B0); PG8_MMA(0, 1, At, B1); PG8_BAR; PG8_SCHED;
            PG8_LDA(At, 1, 1); PG8_STAGE(PG8_SB(1, 0), b3, voffB); PG8_STAGE(PG8_SB(1, 1), b3 + hstep, voffB); PG8_STAGE(PG8_SA(1, 0), a3, a2v0);
            PG8_WAIT_V(8); PG8_WAIT_L(0); PG8_BAR; PG8_MMA(1, 0, At, B0); PG8_MMA(1, 1, At, B1); PG8_BAR; PG8_SCHED;
        }
      }
        const char* nB = rB;
        if constexpr (ALIGN_EPI) { if (wr == 0) PG8_BAR; }
        if constexpr (FP8) asm volatile("s_nop 15\n\ts_nop 15\n\ts_nop 15" ::: "memory");
        E(acc, cur, wr, wc, fr, fq);
#ifdef DUP_EPI
        if constexpr (FP8) { asm volatile("" ::: "memory"); E(acc, cur, wr, wc, fr, fq); }
#endif
        if (!has_next) break;
        E.fetch_sync(pre_n, nxt, wr, wc, fr, fq); E.init(acc, pre_n);
        cur = nxt; cB = nB; ++ui;
        cAv[0][0] = nAv[0][0]; cAv[0][1] = nAv[0][1]; cAv[1][0] = nAv[1][0]; cAv[1][1] = nAv[1][1];
        if constexpr (ALIGN_EPI) { if (wr == 1) PG8_BAR; }
    }
    PG8_WAIT_V(0);
    if constexpr (!ALIGN_EPI) { if (wr == 0) PG8_BAR; }
    PG8_BAR;
#undef PG8_AVOFF
#undef PG8_SA
#undef PG8_SB
#undef PG8_STAGE
#undef PG8_LDA
#undef PG8_LDB
#undef PG8_MMA
#undef PG8_WAIT_V
#undef PG8_WAIT_L
#undef PG8_BAR
#undef PG8_SCHED
}

__device__ __forceinline__ int xcd_remap(int wgid, int nwg) { const int q = nwg / NXCD, r = nwg % NXCD, xcd = wgid % NXCD, off = wgid / NXCD; return (xcd < r ? xcd * (q + 1) : r * (q + 1) + (xcd - r) * q) + off; }

struct PlainSched {
    static constexpr bool FP8 = false; static constexpr int SCALE_W = 0, SCALE_W1 = 0, SCALE_A = 0;
    int nM, nN, nwg, G, c; const char* A; const char* Bt;
    __device__ __forceinline__ void init(int M, int N, int G_, int c_, const void* A_, const void* Bt_) { nM = M / BM; nN = N / BM; nwg = nM * nN; G = G_; c = c_; A = (const char*)A_; Bt = (const char*)Bt_; }
    __device__ __forceinline__ bool next(int i, Unit& u) const {
        const long L = (long)i * G + c; if (L >= nwg) return false;
        const int wgid = xcd_remap((int)L, nwg);
        const int nig = WGM * nN, gid = wgid / nig, fm = gid * WGM, gsz = (nM - fm) < WGM ? (nM - fm) : WGM;
        u.pm = fm + ((wgid % nig) % gsz); u.pn = (wgid % nig) / gsz; u.e = 0; u.slot = i; return true;
    }
    __device__ __forceinline__ const char* a_base() const { return A; }
    __device__ __forceinline__ const char* b_tile(const Unit& u) const { return Bt + (size_t)u.pn * BM * KD * 2; }
    __device__ __forceinline__ void a_voff(const Unit& u, const int (&Rr)[2], const int (&Cc)[2], unsigned (&v)[2][2]) const {
#pragma unroll
        for (int h = 0; h < 2; ++h)
#pragma unroll
            for (int i = 0; i < 2; ++i) v[h][i] = (unsigned)((u.pm * BM + h * HALF + Rr[i]) * (KD * 2) + Cc[i]);
    }
};

template <bool GATHER>
struct MoeSched {
    static constexpr bool FP8 = true; static constexpr int SCALE_W = 0x79797979  , SCALE_A = GATHER ? 0x7B7B7B7B   : 0x7D7D7D7D  ;
    static constexpr int SCALE_W1 = GATHER ? 0x7B7B7B7B   : SCALE_W;
    int nN, nunits, G, c; const char* A; const char* Bt; size_t estride;
    const LAS int* tile_e; const LAS unsigned* rowtab;
    __device__ __forceinline__ bool next(int i, Unit& u) const {
        const long L = (long)i * G + c; if (L >= nunits) return false;
        const int id = xcd_remap((int)L, nunits);
        u.pm = id / nN; u.pn = id % nN; u.e = tile_e[u.pm]; u.slot = i; return true;
    }
    __device__ __forceinline__ const char* a_base() const { return A; }
    __device__ __forceinline__ const char* b_tile(const Unit& u) const { return Bt + (size_t)u.e * estride + (size_t)u.pn * BM * KD; }
    __device__ __forceinline__ void a_voff(const Unit& u, const int (&Rr)[2], const int (&Cc)[2], unsigned (&v)[2][2]) const {
#pragma unroll
        for (int h = 0; h < 2; ++h)
#pragma unroll
            for (int i = 0; i < 2; ++i) {
                if (GATHER) v[h][i] = rowtab[u.slot * 256 + h * HALF + Rr[i]] + (unsigned)Cc[i];
                else v[h][i] = (unsigned)((u.pm * BM + h * HALF + Rr[i]) * KD + Cc[i]);
            }
    }
};

__device__ __forceinline__ void load16_untracked(f32x4& dst, const float* p) { asm volatile("global_load_dwordx4 %0, %1, off" : "=v"(dst) : "v"(p) : "memory"); }
__device__ __forceinline__ void acc_zero(f32x4 (&acc)[2][2][4][2]) {
#pragma unroll
    for (int a = 0; a < 2; ++a)
#pragma unroll
        for (int b = 0; b < 2; ++b)
#pragma unroll
            for (int m = 0; m < 4; ++m)
#pragma unroll
                for (int n = 0; n < 2; ++n) acc[a][b][m][n] = (f32x4){0.f, 0.f, 0.f, 0.f};
}
struct EpiProj {
    static constexpr bool PERM = true;
    bf16_t* O;
    struct Pre { int none; };
    __device__ __forceinline__ void fetch_sync(Pre&, const Unit&, int, int, int, int) const {}
    __device__ __forceinline__ void fetch_async(Pre&, const Unit&, int, int, int, int) const {}
    __device__ __forceinline__ void init(f32x4 (&acc)[2][2][4][2], const Pre&) const { acc_zero(acc); }
    __device__ __forceinline__ void operator()(const f32x4 (&acc)[2][2][4][2], const Unit& u, int wr, int wc, int fr, int fq) const {
        const int row0 = u.pm * BM + wr * 64 + fr, col0 = u.pn * BM + wc * 32 + 8 * fq;
#pragma unroll
        for (int ai = 0; ai < 2; ++ai)
#pragma unroll
            for (int m = 0; m < 4; ++m) { bf16_t* rowp = O + (size_t)(row0 + ai * HALF + m * 16) * INC + col0;
#pragma unroll
                for (int bj = 0; bj < 2; ++bj) { const f32x4 v0 = acc[ai][bj][m][0], v1 = acc[ai][bj][m][1];
                    u32x4 w; w.x = cvt_pk_bf16(v0[0], v0[1]); w.y = cvt_pk_bf16(v0[2], v0[3]); w.z = cvt_pk_bf16(v1[0], v1[1]); w.w = cvt_pk_bf16(v1[2], v1[3]);
                    *(u32x4*)(rowp + bj * HALF) = w; } }
    }
};
struct EpiIn {
    static constexpr bool PERM = true;
    bf16_t* U; bf16_t* QKV; const float* rope;
    struct Pre { int none; };
    __device__ __forceinline__ void fetch_sync(Pre&, const Unit&, int, int, int, int) const {}
    __device__ __forceinline__ void fetch_async(Pre&, const Unit&, int, int, int, int) const {}
    __device__ __forceinline__ void init(f32x4 (&acc)[2][2][4][2], const Pre&) const { acc_zero(acc); }
    __device__ __forceinline__ void operator()(const f32x4 (&acc)[2][2][4][2], const Unit& u, int wr, int wc, int fr, int fq) const {
        const int row0 = u.pm * BM + wr * 64 + fr;
        if (u.pn < 4) {
            const int col0 = u.pn * HALF + wc * 32 + 8 * fq;
#pragma unroll
            for (int ai = 0; ai < 2; ++ai)
#pragma unroll
                for (int m = 0; m < 4; ++m) { const size_t row = (size_t)(row0 + ai * HALF + m * 16);
                    float o[8];
#pragma unroll
                    for (int n = 0; n < 2; ++n)
#pragma unroll
                        for (int j = 0; j < 4; ++j) o[4 * n + j] = acc[ai][0][m][n][j] * fast_sigmoid(acc[ai][1][m][n][j]);
                    u32x4 w; w.x = cvt_pk_bf16(o[0], o[1]); w.y = cvt_pk_bf16(o[2], o[3]); w.z = cvt_pk_bf16(o[4], o[5]); w.w = cvt_pk_bf16(o[6], o[7]);
                    *(u32x4*)(U + row * 512 + col0) = w; }
        } else {
            const int t = u.pn - 4;
            bf16_t* O = QKV + (size_t)(t >> 1) * ((WS_K - WS_Q) / 2);
            const int d0 = (wc & 1) * 32 + 8 * fq, hd0 = (t & 1) * 4 + (wc >> 1);
            const bool rot = (t < 4) && ((wc & 1) == 0) && (fq < 2);
            const int bb = (u.pm * BM) / SEQ, tok0 = (u.pm * BM) % SEQ + wr * 64 + fr;
            f32x4 cs[2][4], sn[2][4];
#pragma unroll
            for (int ai = 0; ai < 2; ++ai)
#pragma unroll
                for (int m = 0; m < 4; ++m) { cs[ai][m] = (f32x4){1.f, 1.f, 1.f, 1.f}; sn[ai][m] = (f32x4){0.f, 0.f, 0.f, 0.f}; }
            if (t < 4) { if (rot) {
#pragma unroll
                for (int ai = 0; ai < 2; ++ai)
#pragma unroll
                    for (int m = 0; m < 4; ++m) { const size_t row = (size_t)(row0 + ai * HALF + m * 16); cs[ai][m] = *(const f32x4*)(rope + row * 16 + 4 * fq); sn[ai][m] = *(const f32x4*)(rope + row * 16 + 8 + 4 * fq); } } }
            asm volatile("" ::: "memory");
#pragma unroll
            for (int ai = 0; ai < 2; ++ai)
#pragma unroll
                for (int m = 0; m < 4; ++m) { const int tok = tok0 + ai * HALF + m * 16;
#pragma unroll
                    for (int bj = 0; bj < 2; ++bj) { const f32x4 x1 = acc[ai][bj][m][0], x2 = acc[ai][bj][m][1];
                        const f32x4 v0 = x1 * cs[ai][m] - x2 * sn[ai][m], v1 = x2 * cs[ai][m] + x1 * sn[ai][m];
                        u32x4 w; w.x = cvt_pk_bf16(v0[0], v0[1]); w.y = cvt_pk_bf16(v0[2], v0[3]); w.z = cvt_pk_bf16(v1[0], v1[1]); w.w = cvt_pk_bf16(v1[2], v1[3]);
                        *(u32x4*)(O + ((size_t)((bb * NH + hd0 + 2 * bj) * SEQ + tok)) * 64 + d0) = w; } }
        }
    }
};
struct EpiOut {
    static constexpr bool PERM = true;
    const float* x; bf16_t* out; const float* mod;
    struct Pre { int none; };
    __device__ __forceinline__ void fetch_sync(Pre&, const Unit&, int, int, int, int) const {}
    __device__ __forceinline__ void fetch_async(Pre&, const Unit&, int, int, int, int) const {}
    __device__ __forceinline__ void init(f32x4 (&acc)[2][2][4][2], const Pre&) const { acc_zero(acc); }
    __device__ __forceinline__ void operator()(const f32x4 (&acc)[2][2][4][2], const Unit& u, int wr, int wc, int fr, int fq) const {
        const int b = (u.pm * BM) / SEQ; const float* g1 = mod + b * 6144 + 2048;
        const int col0 = u.pn * BM + wc * 32 + 8 * fq;
        f32x4 gv[2][2];
#pragma unroll
        for (int bj = 0; bj < 2; ++bj)
#pragma unroll
            for (int n = 0; n < 2; ++n) gv[bj][n] = *(const f32x4*)(g1 + col0 + bj * HALF + n * 4);
#pragma unroll
        for (int ai = 0; ai < 2; ++ai) {
            f32x4 xv[4][2][2];
#pragma unroll
            for (int m = 0; m < 4; ++m) { const size_t off = (size_t)(u.pm * BM + ai * HALF + wr * 64 + m * 16 + fr) * D + col0;
#pragma unroll
                for (int bj = 0; bj < 2; ++bj)
#pragma unroll
                    for (int n = 0; n < 2; ++n) xv[m][bj][n] = *(const f32x4*)(x + off + bj * HALF + n * 4); }
            asm volatile("" ::: "memory");
#pragma unroll
            for (int m = 0; m < 4; ++m) { const size_t off = (size_t)(u.pm * BM + ai * HALF + wr * 64 + m * 16 + fr) * D + col0;
#pragma unroll
                for (int bj = 0; bj < 2; ++bj) { const f32x4 v0 = xv[m][bj][0] + gv[bj][0] * acc[ai][bj][m][0], v1 = xv[m][bj][1] + gv[bj][1] * acc[ai][bj][m][1];
                    u32x4 w; w.x = cvt_pk_bf16(v0[0], v0[1]); w.y = cvt_pk_bf16(v0[2], v0[3]); w.z = cvt_pk_bf16(v1[0], v1[1]); w.w = cvt_pk_bf16(v1[2], v1[3]);
                    *(u32x4*)(out + off + bj * HALF) = w; } }
            asm volatile("" ::: "memory");
        }
    }
};
struct EpiSwiglu {
    static constexpr bool PERM = true;
    unsigned char* ACT; const float* b_gu;
    struct Pre { f32x4 v[4]; };
    __device__ __forceinline__ void fetch_sync(Pre& p, const Unit& u, int wr, int wc, int fr, int fq) const {
        const float* bg = b_gu + (size_t)u.e * 2048 + u.pn * HALF + wc * 32 + 8 * fq;
        p.v[0] = *(const f32x4*)(bg); p.v[1] = *(const f32x4*)(bg + 4); p.v[2] = *(const f32x4*)(bg + 1024); p.v[3] = *(const f32x4*)(bg + 1028);
    }
    __device__ __forceinline__ void fetch_async(Pre& p, const Unit& u, int wr, int wc, int fr, int fq) const {
        const float* bg = b_gu + (size_t)u.e * 2048 + u.pn * HALF + wc * 32 + 8 * fq;
        load16_untracked(p.v[0], bg); load16_untracked(p.v[1], bg + 4); load16_untracked(p.v[2], bg + 1024); load16_untracked(p.v[3], bg + 1028);
    }
    __device__ __forceinline__ void init(f32x4 (&acc)[2][2][4][2], const Pre& p) const {
#pragma unroll
        for (int n = 0; n < 2; ++n) { const f32x4 bgv = p.v[n], buv = (p.v[2 + n] + 1.0f) * 4.0f;
#pragma unroll
            for (int ai = 0; ai < 2; ++ai)
#pragma unroll
                for (int m = 0; m < 4; ++m) { acc[ai][0][m][n] = bgv; acc[ai][1][m][n] = buv; } }
    }
    __device__ __forceinline__ void operator()(const f32x4 (&acc)[2][2][4][2], const Unit& u, int wr, int wc, int fr, int fq) const {
        const int cb = u.pn * HALF + wc * 32 + 8 * fq;
#pragma unroll
        for (int ai = 0; ai < 2; ++ai)
#pragma unroll
            for (int m = 0; m < 4; ++m) { const size_t row = (size_t)u.pm * BM + ai * HALF + wr * 64 + m * 16 + fr;
                float a[8];
#pragma unroll
                for (int n = 0; n < 2; ++n)
#pragma unroll
                    for (int jp = 0; jp < 2; ++jp) { f32x2 g, up;
                        g.x = __builtin_amdgcn_fmed3f(acc[ai][0][m][n][2 * jp], -3.0e38f, 7.0f); g.y = __builtin_amdgcn_fmed3f(acc[ai][0][m][n][2 * jp + 1], -3.0e38f, 7.0f);
                        up.x = __builtin_amdgcn_fmed3f(acc[ai][1][m][n][2 * jp], -24.0f, 32.0f); up.y = __builtin_amdgcn_fmed3f(acc[ai][1][m][n][2 * jp + 1], -24.0f, 32.0f);
                        const f32x2 t = g * (-1.702f * 1.4426950408889634f); f32x2 e; e.x = __builtin_amdgcn_exp2f(t.x); e.y = __builtin_amdgcn_exp2f(t.y);
                        const f32x2 d = e + 1.0f; f32x2 r; r.x = __builtin_amdgcn_rcpf(d.x); r.y = __builtin_amdgcn_rcpf(d.y);
                        const f32x2 o = (up * g) * r; a[4 * n + 2 * jp] = o.x; a[4 * n + 2 * jp + 1] = o.y; }
                u32x2 w; w.x = pk4_fp8(a[0], a[1], a[2], a[3]); w.y = pk4_fp8(a[4], a[5], a[6], a[7]);
                *(u32x2*)(ACT + row * D + cb) = w; }
    }
};
struct EpiDown {
    static constexpr bool PERM = true;
    unsigned char* Y; const float* b_down;
    struct Pre { f32x4 v[4]; };
    __device__ __forceinline__ void fetch_sync(Pre& p, const Unit& u, int wr, int wc, int fr, int fq) const {
        const float* bd = b_down + (size_t)u.e * D + u.pn * BM + wc * 32 + 8 * fq;
        p.v[0] = *(const f32x4*)(bd); p.v[1] = *(const f32x4*)(bd + 4); p.v[2] = *(const f32x4*)(bd + HALF); p.v[3] = *(const f32x4*)(bd + HALF + 4);
    }
    __device__ __forceinline__ void fetch_async(Pre& p, const Unit& u, int wr, int wc, int fr, int fq) const {
        const float* bd = b_down + (size_t)u.e * D + u.pn * BM + wc * 32 + 8 * fq;
        load16_untracked(p.v[0], bd); load16_untracked(p.v[1], bd + 4); load16_untracked(p.v[2], bd + HALF); load16_untracked(p.v[3], bd + HALF + 4);
    }
    __device__ __forceinline__ void init(f32x4 (&acc)[2][2][4][2], const Pre& p) const {
#pragma unroll
        for (int bj = 0; bj < 2; ++bj)
#pragma unroll
            for (int n = 0; n < 2; ++n) { const f32x4 bv = p.v[2 * bj + n];
#pragma unroll
                for (int ai = 0; ai < 2; ++ai)
#pragma unroll
                    for (int m = 0; m < 4; ++m) acc[ai][bj][m][n] = bv; }
    }
    __device__ __forceinline__ void operator()(const f32x4 (&acc)[2][2][4][2], const Unit& u, int wr, int wc, int fr, int fq) const {
        const int col0 = u.pn * BM + wc * 32 + 8 * fq;
#pragma unroll
        for (int ai = 0; ai < 2; ++ai)
#pragma unroll
            for (int m = 0; m < 4; ++m) { unsigned char* rowp = Y + ((size_t)u.pm * BM + ai * HALF + wr * 64 + m * 16 + fr) * D + col0;
#pragma unroll
                for (int bj = 0; bj < 2; ++bj) { const f32x4 v0 = acc[ai][bj][m][0] * 16.0f, v1 = acc[ai][bj][m][1] * 16.0f;
                    u32x2 w; w.x = pk4_fp8(v0[0], v0[1], v0[2], v0[3]); w.y = pk4_fp8(v1[0], v1[1], v1[2], v1[3]);
                    *(u32x2*)(rowp + bj * HALF) = w; } }
    }
};
}

#define XB_TMO      128
#define XB_XCNT(j)  (256  + 64 * (j))
#define XB_XSUB(j)  (1280 + 64 * (j))
#define XB_XGEN(j)  (2304 + 64 * (j))
#define XB_TOP      3328
#define XB_TOPGEN   3392
#define XCD_BAR_WORDS 3456
#define XB_SPIN_CAP (1u << 18)
__device__ __forceinline__ unsigned xb_ld(unsigned* p)              { return __hip_atomic_load(p, __ATOMIC_RELAXED, __HIP_MEMORY_SCOPE_AGENT); }
__device__ __forceinline__ unsigned xb_add(unsigned* p, unsigned v) { return __hip_atomic_fetch_add(p, v, __ATOMIC_RELAXED, __HIP_MEMORY_SCOPE_AGENT); }
__device__ __forceinline__ unsigned xb_xcc_id() { return (unsigned)__builtin_amdgcn_s_getreg((3 << 11) | 20) & 0xFu; }
#define XB_SPIN(cond, bar) do { unsigned _sp = 0; while (cond) { __builtin_amdgcn_s_sleep(1); \
    if ((++_sp & 255u) == 0u) { if (xb_ld(&(bar)[XB_TMO])) break; if (_sp > XB_SPIN_CAP) { atomicAdd(&(bar)[XB_TMO], 1u); break; } } } } while (0)
struct XcdBarrier { unsigned* bar; unsigned x; volatile LAS unsigned* st; };
__device__ __forceinline__ XcdBarrier xcd_barrier_post(unsigned* bar, volatile LAS unsigned* st) {
    XcdBarrier b; b.bar = bar; b.x = xb_xcc_id(); b.st = st;
    if (threadIdx.x == 0) (void)xb_add(&bar[XB_XCNT(b.x)], 1u);
    return b;
}
__device__ __forceinline__ void xcd_barrier_complete(unsigned* bar, unsigned x, unsigned& nloc, unsigned& nx) {
    const unsigned G = gridDim.x * gridDim.y * gridDim.z;
    unsigned sum, cnt, mine, sp = 0u;
    for (;;) {
        sum = 0u; cnt = 0u; mine = 0u;
#pragma unroll
        for (unsigned j = 0; j < 16; ++j) { const unsigned c = xb_ld(&bar[XB_XCNT(j)]); sum += c; cnt += (c > 0u) ? 1u : 0u; mine = (j == x) ? c : mine; }
        if (sum == G) break;
        __builtin_amdgcn_s_sleep(1);
        if ((++sp & 255u) == 0u) { if (xb_ld(&bar[XB_TMO])) break; if (sp > XB_SPIN_CAP) { atomicAdd(&bar[XB_TMO], 1u); break; } }
    }
    nloc = mine > 0u ? mine : 1u; nx = cnt > 0u ? cnt : 1u;
}
__device__ __forceinline__ void xcd_barrier(const XcdBarrier& b) {
    asm volatile("s_waitcnt vmcnt(0)" ::: "memory");
    __syncthreads();
    if (threadIdx.x == 0) {
        unsigned* bar = b.bar;
        __builtin_amdgcn_s_waitcnt(0);
        unsigned nloc = b.st[0], nx = b.st[1];
        if (nloc == 0u) { xcd_barrier_complete(bar, b.x, nloc, nx); b.st[0] = nloc; b.st[1] = nx; }
        const unsigned old = xb_add(&bar[XB_XSUB(b.x)], 1u);
        const unsigned gen = old / nloc;
        if (old + 1u == (gen + 1u) * nloc) {
            __builtin_amdgcn_fence(__ATOMIC_RELEASE, "agent");
            asm volatile("s_waitcnt vmcnt(0)" ::: "memory");
            const unsigned og = xb_add(&bar[XB_TOP], 1u);
            const unsigned tg = og / nx;
            if (og + 1u == (tg + 1u) * nx) xb_add(&bar[XB_TOPGEN], 1u);
            else XB_SPIN(xb_ld(&bar[XB_TOPGEN]) == tg, bar);
            __builtin_amdgcn_fence(__ATOMIC_ACQUIRE, "agent");
            xb_add(&bar[XB_XGEN(b.x)], 1u);
            asm volatile("s_waitcnt vmcnt(0)" ::: "memory");
        } else {
            XB_SPIN(xb_ld(&bar[XB_XGEN(b.x)]) == gen, bar);
            __builtin_amdgcn_fence(__ATOMIC_ACQUIRE, "agent");
            asm volatile("s_waitcnt vmcnt(0)" ::: "memory");
        }
    }
    __syncthreads();
}

struct Args {
    const float* x; const float* c; const int* pos; const float* w_ada; const float* b_ada; const float* g_mix; const float* w_in;
    const float* conv_w; const float* conv_b; const float* ln_g; const float* ln_b; const float* w_out; const float* g_ffn;
    const float* w_router; const float* b_router; const float* w_gu; const float* b_gu; const float* w_down; const float* b_down; const float* g_final;
    float* out; unsigned char* ws; int ph_lo, ph_hi;
};
struct Frame {
    LAS unsigned char* lds; int tid, lane, wave, G, blk;
};

__device__ __forceinline__ void transpose_item(const float* W, int N, bf16_t* WT, int k0, int n0, int srccol, LAS float* scr, int lane) {
    float tv_[32];
#pragma unroll
    for (int i = 0; i < 32; ++i) tv_[i] = W[(size_t)(k0 + 2 * i + (lane >> 5)) * N + srccol];
#pragma unroll
    for (int i = 0; i < 32; ++i) scr[(2 * i + (lane >> 5)) * 33 + (lane & 31)] = tv_[i];
    asm volatile("s_waitcnt lgkmcnt(0)" ::: "memory");
    const int c = lane & 7;
#pragma unroll
    for (int j = 0; j < 4; ++j) { const int n = (lane >> 3) + 8 * j; const LAS float* s = scr + (8 * c) * 33 + n;
        u32x4 o; o.x = pk2(s[0 * 33], s[1 * 33]); o.y = pk2(s[2 * 33], s[3 * 33]); o.z = pk2(s[4 * 33], s[5 * 33]); o.w = pk2(s[6 * 33], s[7 * 33]);
        *(u32x4*)(WT + (size_t)(n0 + n) * 1024 + k0 + 8 * c) = o; }
    asm volatile("s_waitcnt lgkmcnt(0)" ::: "memory");
}
__device__ __forceinline__ int srccol_in(int n) {
    if (n < 1024) { const int t = n >> 8, w = n & 255; return w < 128 ? 128 * t + w : 512 + 128 * t + (w - 128); }
    if (n < 2048) { const int p = n & 63; return (n & ~63) + (p < 16 ? 4 * (p >> 3) + (p & 3) + 8 * ((p >> 2) & 1) : p); }
    return n;
}
__device__ __forceinline__ int srccol_gu(int n) { const int t = n >> 8, w = n & 255; return w < 128 ? 128 * t + w : 1024 + 128 * t + (w - 128); }

__device__ __forceinline__ void transpose_item_f8(const float* W, int N, unsigned char* WT, int k0, int n0, int srccol, LAS float* scr, int lane) {
    float tv_[32];
#pragma unroll
    for (int i = 0; i < 32; ++i) tv_[i] = W[(size_t)(k0 + 2 * i + (lane >> 5)) * N + srccol];
#pragma unroll
    for (int i = 0; i < 32; ++i) scr[(2 * i + (lane >> 5)) * 33 + (lane & 31)] = tv_[i];
    asm volatile("s_waitcnt lgkmcnt(0)" ::: "memory");
    const int c = lane & 7;
#pragma unroll
    for (int j = 0; j < 4; ++j) { const int n = (lane >> 3) + 8 * j; const LAS float* s = scr + (8 * c) * 33 + n;
        u32x2 o; o.x = pk4_fp8(64.0f * s[0 * 33], 64.0f * s[1 * 33], 64.0f * s[2 * 33], 64.0f * s[3 * 33]); o.y = pk4_fp8(64.0f * s[4 * 33], 64.0f * s[5 * 33], 64.0f * s[6 * 33], 64.0f * s[7 * 33]);
        *(u32x2*)(WT + (size_t)(n0 + n) * 1024 + k0 + 8 * c) = o; }
    asm volatile("s_waitcnt lgkmcnt(0)" ::: "memory");
}
__device__ __forceinline__ void p0_mod_gemv(const Args& a, Frame& F) {
    unsigned char* ws = a.ws;
    LAS float* cact = (LAS float*)F.lds;
    LAS float* part = (LAS float*)(F.lds + 16384);
    const int r8 = F.lane >> 3, c4 = F.lane & 7;
    const float* wp = a.w_ada + (size_t)(F.wave * 128 + r8) * 6144 + F.blk * 32 + 4 * c4;
    f32x4 wv[16];
#pragma unroll
    for (int i = 0; i < 16; ++i) wv[i] = *(const f32x4*)(wp + (size_t)(8 * i) * 6144);
    { const f32x4 c0 = *(const f32x4*)(a.c + 8 * F.tid), c1 = *(const f32x4*)(a.c + 8 * F.tid + 4);
      f32x4 s0, s1;
#pragma unroll
      for (int q = 0; q < 4; ++q) { s0[q] = c0[q] / (1.0f + __expf(-c0[q])); s1[q] = c1[q] / (1.0f + __expf(-c1[q])); }
      *(LAS f32x4*)(cact + 8 * F.tid) = s0; *(LAS f32x4*)(cact + 8 * F.tid + 4) = s1; }
    __syncthreads();
    f32x4 acc[4];
#pragma unroll
    for (int bb = 0; bb < 4; ++bb) acc[bb] = (f32x4){0.f, 0.f, 0.f, 0.f};
#pragma unroll
    for (int i = 0; i < 16; ++i) { const int k = F.wave * 128 + 8 * i + r8;
#pragma unroll
        for (int bb = 0; bb < 4; ++bb) acc[bb] += wv[i] * cact[bb * 1024 + k]; }
#pragma unroll
    for (int bb = 0; bb < 4; ++bb)
#pragma unroll
        for (int q = 0; q < 4; ++q) { float v = acc[bb][q]; v += __shfl_xor(v, 8); v += __shfl_xor(v, 16); v += __shfl_xor(v, 32); acc[bb][q] = v; }
    if (F.lane < 8) {
#pragma unroll
        for (int bb = 0; bb < 4; ++bb) *(LAS f32x4*)(part + (F.wave * 4 + bb) * 32 + 4 * c4) = acc[bb]; }
    __syncthreads();
    if (F.tid < 128) { const int bb = F.tid >> 5, l = F.tid & 31; float sum = a.b_ada[F.blk * 32 + l];
#pragma unroll
        for (int w = 0; w < 8; ++w) sum += part[(w * 4 + bb) * 32 + l];
        ((float*)(ws + WS_MOD))[bb * 6144 + F.blk * 32 + l] = sum; }
    __syncthreads();
}
__device__ __forceinline__ void p0_prologue(const Args& a, Frame& F) {
    unsigned char* ws = a.ws;
    LAS float* scr = (LAS float*)(F.lds + F.wave * 16384);
    const bool split = F.G >= 192 + 32;
    if (split ? (F.blk < 192) : true) { if (split) p0_mod_gemv(a, F); }
    const int blk2 = split ? (int)((F.blk + F.G - 192) % F.G) : (int)F.blk;
    const int gw = blk2 * 8 + F.wave, NGW = F.G * 8;
    constexpr int I_IN = 16 * 80, I_OUT = 16 * 32, I_GU1 = 16 * 64, I_GU = 32 * I_GU1, I_DN1 = 16 * 32, I_DN = 32 * I_DN1;
    constexpr int NITEMS = I_IN + I_OUT + I_GU + I_DN;
    for (int it = gw; it < (BG_IN_ATTN ? I_IN + I_OUT : NITEMS); it += NGW) {
        int r = it;
        if (BG_IN_ATTN) r += I_GU + I_DN;
        if (r < I_GU) { const int e = r / I_GU1, q = r % I_GU1, kb = q / 64, nb = q % 64; const int n = nb * 32 + (F.lane & 31);
            transpose_item_f8(a.w_gu + (size_t)e * 1024 * 2048, 2048, ws + WS_WGU + (size_t)e * 2048 * 1024, kb * 64, nb * 32, srccol_gu(n), scr, F.lane); continue; }
        r -= I_GU;
        if (r < I_DN) { const int e = r / I_DN1, q = r % I_DN1, kb = q / 32, nb = q % 32;
            transpose_item_f8(a.w_down + (size_t)e * 1024 * 1024, 1024, ws + WS_WDOWN + (size_t)e * 1024 * 1024, kb * 64, nb * 32, nb * 32 + (F.lane & 31), scr, F.lane); continue; }
        r -= I_DN;
        if (r < I_IN) { const int kb = r / 80, nb = r % 80;
            transpose_item(a.w_in, INC, (bf16_t*)(ws + WS_WIN), kb * 64, nb * 32, FUSE_SPLIT ? srccol_in(nb * 32 + (F.lane & 31)) : nb * 32 + (F.lane & 31), scr, F.lane); continue; }
        r -= I_IN;
        { const int kb = r / 32, nb = r % 32;
            transpose_item(a.w_out, 1024, (bf16_t*)(ws + WS_WOUT), kb * 64, nb * 32, nb * 32 + (F.lane & 31), scr, F.lane); }
    }
    {
        const float inv_freq[8] = {1.0f, 0.19392274474868576f, 0.03760603093086393f, 0.007292664737217109f, 0.001414213562373095f, 0.0002742481756762073f, 5.318295896944988e-05f, 1.031338537721246e-05f};
        float* rope = (float*)(ws + WS_ROPE);
        for (int idx = blk2 * 512 + F.tid; idx < T * 8; idx += (int)F.G * 512) {
            const int tkn = idx >> 3, i = idx & 7;
            float fr = 1.0f;
#pragma unroll
            for (int q = 0; q < 8; ++q) fr = (i == q) ? inv_freq[q] : fr;
            const float angf = (float)a.pos[tkn] * fr;
            const double ang = (double)angf;
            const double kq = __builtin_rint(ang * 0.63661977236758134308);
            const double y = (ang - kq * 1.57079632679489655800) - kq * 6.123233995736766036e-17;
            const double y2 = y * y;
            const double sn = y * (1.0 + y2 * (-1.0 / 6 + y2 * (1.0 / 120 + y2 * (-1.0 / 5040 + y2 * (1.0 / 362880 + y2 * (-1.0 / 39916800 + y2 * (1.0 / 6227020800.0)))))));
            const double cs = 1.0 + y2 * (-0.5 + y2 * (1.0 / 24 + y2 * (-1.0 / 720 + y2 * (1.0 / 40320 + y2 * (-1.0 / 3628800 + y2 * (1.0 / 479001600.0 + y2 * (-1.0 / 87178291200.0)))))));
            const int qd = ((int)kq) & 3;
            const double c_ = (qd == 0) ? cs : (qd == 1) ? -sn : (qd == 2) ? -cs : sn;
            const double s_ = (qd == 0) ? sn : (qd == 1) ? cs : (qd == 2) ? -sn : -cs;
            rope[tkn * 16 + i] = (float)c_; rope[tkn * 16 + 8 + i] = (float)s_;
        }
    }
    if (!split) { __syncthreads(); for (int g = 0; g < 192; ++g) { Frame F2 = F; F2.blk = g; p0_mod_gemv(a, F2); } }
}

__device__ __forceinline__ void p1_norm1(const Args& a, Frame& F) {
    const float* mod = (const float*)(a.ws + WS_MOD);
    bf16_t* H = (bf16_t*)(a.ws + WS_H);
    const int gw = F.blk * 8 + F.wave, NGW = F.G * 8;
    f32x4 gm[4];
#pragma unroll
    for (int j = 0; j < 4; ++j) gm[j] = *(const f32x4*)(a.g_mix + 4 * F.lane + 256 * j);
#pragma unroll 1
    for (int m0 = 2 * gw; m0 < T; m0 += 2 * NGW) {
        const int b = m0 / SEQ;
        f32x4 v[2][4], shv[4], scv[4]; float ss[2];
#pragma unroll
        for (int t = 0; t < 2; ++t) { const f32x4* xr = (const f32x4*)(a.x + (size_t)(m0 + t) * D) + F.lane;
#pragma unroll
            for (int j = 0; j < 4; ++j) v[t][j] = xr[64 * j]; }
#pragma unroll
        for (int j = 0; j < 4; ++j) { const int col = 4 * F.lane + 256 * j; shv[j] = *(const f32x4*)(mod + b * 6144 + col); scv[j] = *(const f32x4*)(mod + b * 6144 + 1024 + col); }
#pragma unroll
        for (int t = 0; t < 2; ++t) { float s = 0.f;
#pragma unroll
            for (int j = 0; j < 4; ++j) s += (v[t][j].x * v[t][j].x + v[t][j].y * v[t][j].y) + (v[t][j].z * v[t][j].z + v[t][j].w * v[t][j].w);
            ss[t] = s; }
#pragma unroll
        for (int t = 0; t < 2; ++t) {
            const float rstd = 1.0f / sqrtf(wave_sum(ss[t]) * (1.0f / D) + NORM_EPS);
            u32x2* o8 = (u32x2*)(H + (size_t)(m0 + t) * D) + F.lane;
#pragma unroll
            for (int j = 0; j < 4; ++j) { const f32x4 h = (v[t][j] * rstd * gm[j]) * (scv[j] + 1.0f) + shv[j];
                u32x2 w; w.x = pk2(h.x, h.y); w.y = pk2(h.z, h.w); o8[64 * j] = w; } }
    }
}

__device__ __forceinline__ void p3_split(const Args& a, Frame& F) {
    const bf16_t* PR = (const bf16_t*)(a.ws + WS_PROJ);
    bf16_t* U = (bf16_t*)(a.ws + WS_U); bf16_t* Q = (bf16_t*)(a.ws + WS_Q); bf16_t* K = (bf16_t*)(a.ws + WS_K); bf16_t* V = (bf16_t*)(a.ws + WS_V);
    const float* rope = (const float*)(a.ws + WS_ROPE);
    const int gw = F.blk * 8 + F.wave, NGW = F.G * 8, l = F.lane;
    for (int m = gw; m < T; m += NGW) {
        const bf16_t* pr = PR + (size_t)m * INC;
        const u32x4 av = *(const u32x4*)(pr + 8 * l), gv = *(const u32x4*)(pr + 512 + 8 * l);
        u32x4 uo;
#pragma unroll
        for (int j = 0; j < 4; ++j) { const float a0 = bf_lo(av[j]), a1 = bf_hi(av[j]), g0 = bf_lo(gv[j]), g1 = bf_hi(gv[j]);
            uo[j] = pk2(a0 * fast_sigmoid(g0), a1 * fast_sigmoid(g1)); }
        *(u32x4*)(U + (size_t)m * 512 + 8 * l) = uo;
        const f32x4 c0 = *(const f32x4*)(rope + m * 16), c1 = *(const f32x4*)(rope + m * 16 + 4), s0 = *(const f32x4*)(rope + m * 16 + 8), s1 = *(const f32x4*)(rope + m * 16 + 12);
        const float cs[8] = {c0.x, c0.y, c0.z, c0.w, c1.x, c1.y, c1.z, c1.w}, sn[8] = {s0.x, s0.y, s0.z, s0.w, s1.x, s1.y, s1.z, s1.w};
#pragma unroll
        for (int which = 0; which < 2; ++which) {
            const u32x4 qv = *(const u32x4*)(pr + 1024 + 512 * which + 8 * l);
            float xv[8], ov[8];
#pragma unroll
            for (int j = 0; j < 4; ++j) { xv[2 * j] = bf_lo(qv[j]); xv[2 * j + 1] = bf_hi(qv[j]); }
#pragma unroll
            for (int i = 0; i < 8; ++i) ov[i] = __shfl_xor(xv[i], 1);
            const int sel = l & 7;
            u32x4 qo;
#pragma unroll
            for (int j = 0; j < 4; ++j) {
                float r0 = xv[2 * j], r1 = xv[2 * j + 1];
                if (sel == 0) { r0 = xv[2 * j] * cs[2 * j] - ov[2 * j] * sn[2 * j]; r1 = xv[2 * j + 1] * cs[2 * j + 1] - ov[2 * j + 1] * sn[2 * j + 1]; }
                else if (sel == 1) { r0 = xv[2 * j] * cs[2 * j] + ov[2 * j] * sn[2 * j]; r1 = xv[2 * j + 1] * cs[2 * j + 1] + ov[2 * j + 1] * sn[2 * j + 1]; }
                qo[j] = pk2(r0, r1); }
            *(u32x4*)((which ? K : Q) + (size_t)m * 512 + 8 * l) = qo;
        }
        *(u32x4*)(V + (size_t)m * 512 + 8 * l) = *(const u32x4*)(pr + 2048 + 8 * l);
    }
}

__device__ __forceinline__ void conv_unit(const Args& a, Frame& F, int cu, const f32x2 (&wgt)[31], f32x2 bias) {
    const bf16_t* U = (const bf16_t*)(a.ws + WS_U); bf16_t* MIX = (bf16_t*)(a.ws + WS_MIX);
    const int b = cu / 128, t0 = (cu % 128) * 64;
    const int half = F.wave >> 2, cq = F.wave & 3, c0 = 128 * cq + 2 * F.lane;
    const int ts = t0 + 32 * half;
    const bf16_t* Ub = U + (size_t)b * SEQ * 512 + c0;
    LAS float* yt = (LAS float*)F.lds;
    unsigned rawA[31], rawB[31];
#pragma unroll
    for (int jj = 0; jj < 31; ++jj) { const int tin = ts - 30 + jj; const int tc = tin < 0 ? 0 : tin; const unsigned r = *(const unsigned*)(Ub + (size_t)tc * 512); rawA[jj] = tin < 0 ? 0u : r; }
#pragma unroll
    for (int jj = 0; jj < 31; ++jj) rawB[jj] = *(const unsigned*)(Ub + (size_t)(ts + 1 + jj) * 512);
    f32x2 win[31];
#pragma unroll 1
    for (int o = 0; o < 2; ++o) {
#pragma unroll
        for (int jj = 0; jj < 31; ++jj) {
            const int j = 31 * o + jj;
            const unsigned raw = o ? rawB[jj] : rawA[jj];
            f32x2 v; v.x = bf_lo(raw); v.y = bf_hi(raw);
            win[jj] = v;
            if (j >= 30) { f32x2 acc = bias;
#pragma unroll
                for (int tap = 0; tap < 31; ++tap) acc += wgt[tap] * win[(jj + 1 + tap) % 31];
                *(LAS f32x2*)(yt + (32 * half + j - 30) * 512 + c0) = acc; }
        }
    }
    __syncthreads();
    const f32x4 g0 = *(const f32x4*)(a.ln_g + 4 * F.lane), g1 = *(const f32x4*)(a.ln_g + 256 + 4 * F.lane), b0 = *(const f32x4*)(a.ln_b + 4 * F.lane), b1 = *(const f32x4*)(a.ln_b + 256 + 4 * F.lane);
#pragma unroll 1
    for (int i = 0; i < 8; ++i) { const int tl = 8 * F.wave + i; const LAS float* row = yt + tl * 512;
        f32x4 v0 = *(const LAS f32x4*)(row + 4 * F.lane), v1 = *(const LAS f32x4*)(row + 256 + 4 * F.lane);
        const float mean = wave_sum((v0.x + v0.y) + (v0.z + v0.w) + (v1.x + v1.y) + (v1.z + v1.w)) * (1.0f / 512.0f);
        v0 = v0 - mean; v1 = v1 - mean;
        const float var = wave_sum((v0.x * v0.x + v0.y * v0.y) + (v0.z * v0.z + v0.w * v0.w) + (v1.x * v1.x + v1.y * v1.y) + (v1.z * v1.z + v1.w * v1.w)) * (1.0f / 512.0f);
        const float rstd = 1.0f / sqrtf(var + NORM_EPS);
        f32x4 y0 = v0 * rstd * g0 + b0, y1 = v1 * rstd * g1 + b1;
#pragma unroll
        for (int q = 0; q < 4; ++q) { y0[q] = y0[q] * fast_sigmoid(y0[q]); y1[q] = y1[q] * fast_sigmoid(y1[q]); }
        bf16_t* orow = MIX + ((size_t)b * SEQ + t0 + tl) * D;
        u32x2 w0, w1; w0.x = pk2(y0.x, y0.y); w0.y = pk2(y0.z, y0.w); w1.x = pk2(y1.x, y1.y); w1.y = pk2(y1.z, y1.w);
        *(u32x2*)(orow + 4 * F.lane) = w0; *(u32x2*)(orow + 256 + 4 * F.lane) = w1; }
    __syncthreads();
}
__device__ __forceinline__ void p4_conv(const Args& a, Frame& F) {
    const int cq = F.wave & 3, c0 = 128 * cq + 2 * F.lane;
    f32x2 wgt[31];
#pragma unroll
    for (int j = 0; j < 31; ++j) wgt[j] = *(const f32x2*)(a.conv_w + j * 512 + c0);
    const f32x2 bias = *(const f32x2*)(a.conv_b + c0);
    for (int cu = F.blk; cu < 512; cu += F.G) conv_unit(a, F, cu, wgt, bias);
}

namespace att {
constexpr int ST_OFF = 0, ML_OFF = 65536, VB_OFF = 69632;
constexpr float CSC = 0.125f * 1.4426950408889634f;
__device__ __forceinline__ unsigned st_addr(int row, int ch8) { const int swz = (row & 15) ^ ((row >> 4) & 15); return (unsigned)(ST_OFF + row * 128 + ((ch8 ^ swz) << 3)); }


#ifndef BG_CVT_SCALE
#define BG_CVT_SCALE 0.015625f
#endif
constexpr int BG_ITEMS = 65536 + 32768;
constexpr int BG_OFF = 102400;
__device__ __forceinline__ void bg_decode(const Args& a, int it, int lane, const float*& W, int& N, unsigned char*& dst, int& k0, int& n0, int& src) {
    if (it < 65536) { const int e = it >> 11, q = it & 2047, kb = q >> 6, nb = q & 63; W = a.w_gu + (size_t)e * 1024 * 2048; N = 2048; dst = a.ws + WS_WGU + (size_t)e * 2048 * 1024; k0 = kb * 32; n0 = nb * 32; src = srccol_gu(n0 + (lane & 31)); }
    else { const int r = it - 65536, e = r >> 10, q = r & 1023, kb = q >> 5, nb = q & 31; W = a.w_down + (size_t)e * 1024 * 1024; N = 1024; dst = a.ws + WS_WDOWN + (size_t)e * 1024 * 1024; k0 = kb * 32; n0 = nb * 32; src = n0 + (lane & 31); }
}
__device__ __forceinline__ void bg_issue(const Args& a, int it_, int lane, float (&tmp)[16]) {
    const int it0 = __builtin_amdgcn_readfirstlane(it_);
    const bool valid = it0 < BG_ITEMS; const int it = valid ? it0 : 0;
    const float* W; int N, k0, n0, src; unsigned char* dst; bg_decode(a, it, lane, W, N, dst, k0, n0, src);
    const unsigned boff = (unsigned)((lane >> 5) * 16 * N + src) * 4u;
    const __amdgpu_buffer_rsrc_t rs = __builtin_amdgcn_make_buffer_rsrc((void*)W, 0, valid ? (int)(1024u * 2048u * 4u) : 0, 0x00020000);
#pragma unroll
    for (int i = 0; i < 16; ++i) tmp[i] = __builtin_bit_cast(float, __builtin_amdgcn_raw_buffer_load_b32(rs, (int)boff, (k0 + i) * N * 4, 2  ));
}
__device__ __forceinline__ void bg_finish(const Args& a, int it_, int lane, const float (&tmp)[16], LAS float* scr) {
    const int it0 = __builtin_amdgcn_readfirstlane(it_);
    const bool valid = it0 < BG_ITEMS; const int it = valid ? it0 : 0;
    const float* W; int N, k0, n0, src; unsigned char* dst; bg_decode(a, it, lane, W, N, dst, k0, n0, src);
    u32x4 o;
#pragma unroll
    for (int q = 0; q < 4; ++q) { typedef short v2s_ __attribute__((ext_vector_type(2))); v2s_ r = {0, 0};
        r = __builtin_amdgcn_cvt_scalef32_pk_fp8_f32(r, tmp[4 * q], tmp[4 * q + 1], BG_CVT_SCALE, false); r = __builtin_amdgcn_cvt_scalef32_pk_fp8_f32(r, tmp[4 * q + 2], tmp[4 * q + 3], BG_CVT_SCALE, true);
        o[q] = __builtin_bit_cast(unsigned, r); }
    const __amdgpu_buffer_rsrc_t rd = __builtin_amdgcn_make_buffer_rsrc((void*)dst, 0, valid ? (int)(2048u * 1024u) : 0, 0x00020000);
    __builtin_amdgcn_raw_buffer_store_b128(o, rd, (n0 + (lane & 31)) * 1024 + k0 + 16 * (lane >> 5), 0, 0);
}
#define BG_STEP(X) do { bg_finish(a, bg.it##X - bg_stride, lane, bg.tmp##X, bg_scr); bg_issue(a, bg.it##X, lane, bg.tmp##X); bg.it##X += bg_stride; } while (0)
struct BgState { int itA, itB, liveA, liveB; float tmpA[16], tmpB[16]; };

struct AttRegs { bf16x8 qf[4], kf[4]; u32x4 vv[4]; };
__device__ __forceinline__ void att_next_v(AttRegs& R, const bf16_t* V, int dil, int b, int h, int tq0, int lane) {
    const unsigned char* Vb = (const unsigned char*)(V + (size_t)(b * NH + h) * SEQ * 64);
#pragma unroll
    for (int c = 0; c < 4; ++c) { const int row_ = 8 * c + (lane >> 3), pos_ = lane & 7, ch_ = pos_ ^ (((row_ >> 1) & 1) << 2);
        int tv_ = tq0 + dil * row_; tv_ = tv_ < 0 ? 0 : tv_; R.vv[c] = *(const u32x4*)(Vb + (unsigned)(tv_ * 128 + ch_ * 16)); }
}
__device__ __forceinline__ void att_next_qk(AttRegs& R, const bf16_t* Q, const bf16_t* K, int dil, int b, int h, int tq0, int lane) {
    const int n = lane & 31, hh = lane >> 5;
    const size_t hrow = (size_t)(b * NH + h) * SEQ;
    const unsigned char* Qb = (const unsigned char*)(Q + hrow * 64); const unsigned char* Kb = (const unsigned char*)(K + hrow * 64);
    const unsigned off = (unsigned)((tq0 + dil * n) * 128 + 16 * hh);
#pragma unroll
    for (int s = 0; s < 4; ++s) R.qf[s] = *(const bf16x8*)(Qb + off + 32 * s);
#pragma unroll
    for (int s = 0; s < 4; ++s) R.kf[s] = *(const bf16x8*)(Kb + off + 32 * s);
}
template <int STAGE, int DIL>
__device__ __forceinline__ void wave_tile(const Args& a, BgState& bg, int bg_stride, AttRegs& R, const bf16_t* Q, const bf16_t* K, const bf16_t* V, bf16_t* MIX, int b, int h, int T0, int tq0, int ndil, int nb, int nh, int ntq0, LAS unsigned char* lds, int wave, int lane) {
    LAS float* bg_scr = (LAS float*)(lds + BG_OFF + wave * 4224);
    const int n = lane & 31, hh = lane >> 5;
    const size_t rowb = (size_t)b * SEQ;
    const int tq = tq0 + DIL * n;
    const size_t hrow = (size_t)(b * NH + h) * SEQ;
    bf16x8 (&qf)[4] = R.qf;
    int jmin = 128 - tq0 / DIL; jmin = jmin < 0 ? 0 : jmin;
    const int kt_min = jmin >> 5;
    f32x16 o0, o1;
#pragma unroll
    for (int r = 0; r < 16; ++r) { o0[r] = 0.f; o1[r] = 0.f; }
    float mrun = -1e30f, lrun = 0.f;
    LAS unsigned char* vb = lds + VB_OFF + wave * 8192;
    const int tk0 = tq0 - 128 * DIL;
    const int blk = (lane >> 4) & 1, q4 = (lane & 15) >> 2, p4 = lane & 3, n4 = n - 4 * hh;
    const unsigned char* Kb = (const unsigned char*)(K + hrow * 64); const unsigned char* Vb = (const unsigned char*)(V + hrow * 64);
    bf16x8 (&kf)[4] = R.kf; u32x4 (&vv)[4] = R.vv;
#define ATT_ISSUE_K(KT, KF) do { int tk_ = tk0 + DIL * (32 * (KT) + n); tk_ = tk_ < 0 ? 0 : tk_; const unsigned ko_ = (unsigned)(tk_ * 128 + 16 * hh); \
        _Pragma("unroll") for (int s = 0; s < 4; ++s) KF[s] = *(const bf16x8*)(Kb + ko_ + 32 * s); } while (0)
#define ATT_ISSUE_V(KT, VV) do { _Pragma("unroll") for (int c = 0; c < 4; ++c) { const int row_ = 8 * c + (lane >> 3), pos_ = lane & 7, ch_ = pos_ ^ (((row_ >> 1) & 1) << 2); \
            int tv_ = tk0 + DIL * (32 * (KT) + row_); tv_ = tv_ < 0 ? 0 : tv_; VV[c] = *(const u32x4*)(Vb + (unsigned)(tv_ * 128 + ch_ * 16)); } } while (0)
#define ATT_TILE(KT, BUF) do { \
        _Pragma("unroll") for (int c = 0; c < 4; ++c) *(LAS u32x4*)(vb + (BUF) * 4096 + c * 1024 + lane * 16) = vv[c]; \
        if ((KT) > 0) ATT_ISSUE_V((KT) - 1, vv); else att_next_v(R, V, ndil, nb, nh, ntq0, lane); \
        f32x16 st; _Pragma("unroll") for (int r = 0; r < 16; ++r) st[r] = 0.f; \
        _Pragma("unroll") for (int s = 0; s < 4; ++s) st = __builtin_amdgcn_mfma_f32_32x32x16_bf16(kf[s], qf[s], st, 0, 0, 0); \
        __builtin_amdgcn_sched_barrier(0); \
        if ((KT) > 0) ATT_ISSUE_K((KT) - 1, kf); else att_next_qk(R, Q, K, ndil, nb, nh, ntq0, lane);     \
        __builtin_amdgcn_sched_barrier(0); \
        if ((KT) == 4) { _Pragma("unroll") for (int r = 0; r < 16; ++r) st[r] = ((r & 3) + 8 * (r >> 2) <= n4) ? st[r] : -3.0e38f; }            \
        else if ((KT) == 0 || jmin > 32 * (KT)) { const int lo4 = ((KT) == 0 ? (jmin > n ? jmin : n) : jmin - 32 * (KT)) - 4 * hh; \
            _Pragma("unroll") for (int r = 0; r < 16; ++r) st[r] = ((r & 3) + 8 * (r >> 2) >= lo4) ? st[r] : -3.0e38f; } \
        float mx = fmaxf(fmaxf(st[0], st[1]), fmaxf(st[2], st[3])); \
        _Pragma("unroll") for (int r = 4; r < 16; r += 4) mx = fmaxf(mx, fmaxf(fmaxf(st[r], st[r + 1]), fmaxf(st[r + 2], st[r + 3]))); \
        mx *= CSC;                                    \
        if (__any(mx > mrun + 8.0f)) { mx = fmaxf(mx, __shfl_xor(mx, 32)); const float mnew = fmaxf(mrun, mx), alpha = __builtin_amdgcn_exp2f(mrun - mnew); lrun *= alpha; mrun = mnew; \
            _Pragma("unroll") for (int r = 0; r < 16; ++r) { o0[r] *= alpha; o1[r] *= alpha; } } \
        float pp[16]; float ls = 0.f; \
        _Pragma("unroll") for (int r = 0; r < 16; ++r) { pp[r] = __builtin_amdgcn_exp2f(__builtin_fmaf(st[r], CSC, -mrun)); ls += pp[r]; } \
        lrun += ls; \
        bf16x8 pb[2]; \
        _Pragma("unroll") for (int s2 = 0; s2 < 2; ++s2) { u32x4 w; w.x = cvt_pk_bf16(pp[8 * s2 + 0], pp[8 * s2 + 1]); w.y = cvt_pk_bf16(pp[8 * s2 + 2], pp[8 * s2 + 3]); w.z = cvt_pk_bf16(pp[8 * s2 + 4], pp[8 * s2 + 5]); w.w = cvt_pk_bf16(pp[8 * s2 + 6], pp[8 * s2 + 7]); \
            pb[s2] = __builtin_bit_cast(bf16x8, w); } \
        _Pragma("unroll") for (int db = 0; db < 2; ++db) _Pragma("unroll") for (int s2 = 0; s2 < 2; ++s2) { \
            const s16x4 lo = __builtin_bit_cast(s16x4, __builtin_amdgcn_ds_read_tr16_b64_v4i16((LAS s16x4*)((db ? vtr1 : vtr0) + (BUF) * 4096 + s2 * 2048))); \
            const s16x4 hi = __builtin_bit_cast(s16x4, __builtin_amdgcn_ds_read_tr16_b64_v4i16((LAS s16x4*)((db ? vtr1 : vtr0) + (BUF) * 4096 + s2 * 2048 + 1024))); \
            const bf16x8 vf = (bf16x8){lo[0], lo[1], lo[2], lo[3], hi[0], hi[1], hi[2], hi[3]}; \
            if (db == 0) o0 = __builtin_amdgcn_mfma_f32_32x32x16_bf16(vf, pb[s2], o0, 0, 0, 0); else o1 = __builtin_amdgcn_mfma_f32_32x32x16_bf16(vf, pb[s2], o1, 0, 0, 0); } \
        __builtin_amdgcn_sched_barrier(0); } while (0)
    LAS unsigned char* vtr0; LAS unsigned char* vtr1;
    { const int row = 4 * hh + q4, ch = 2 * blk + (p4 >> 1); const int off = row * 128 + ((ch ^ (((row >> 1) & 1) << 2)) << 4) + 8 * (p4 & 1); vtr0 = vb + off; vtr1 = vb + (off ^ 64); }
    ATT_TILE(4, 0);
    BG_STEP(A);
    ATT_TILE(3, 1);
    BG_STEP(B);
    ATT_TILE(2, 0);
    BG_STEP(A);
    ATT_TILE(1, 1);
    ATT_TILE(0, 0);
    BG_STEP(B);
#undef ATT_ISSUE_K
#undef ATT_ISSUE_V
#undef ATT_TILE
    const float ltot = lrun + __shfl_xor(lrun, 32);
    const int row = tq - T0;
    LAS f32x2* ml = (LAS f32x2*)(lds + ML_OFF);
    float wa, wb = 0.f, inv;
    if (STAGE == 0) { wa = 1.0f; inv = 1.0f / ltot; }
    else { const f32x2 s = ml[row]; const float m2 = fmaxf(mrun, s.x); wa = __builtin_amdgcn_exp2f(mrun - m2); wb = s.y * __builtin_amdgcn_exp2f(s.x - m2);
        const float l2 = ltot * wa + wb; inv = 1.0f / l2; mrun = m2; lrun = l2; }
    if (STAGE == 0) lrun = ltot;
    wa *= inv; wb *= inv;
#pragma unroll
    for (int db = 0; db < 2; ++db)
#pragma unroll
        for (int rq = 0; rq < 4; ++rq) {
            const int ch8 = 8 * db + 2 * rq + hh;
            float v0 = (db ? o1[4 * rq + 0] : o0[4 * rq + 0]) * wa, v1 = (db ? o1[4 * rq + 1] : o0[4 * rq + 1]) * wa, v2 = (db ? o1[4 * rq + 2] : o0[4 * rq + 2]) * wa, v3 = (db ? o1[4 * rq + 3] : o0[4 * rq + 3]) * wa;
            if (STAGE != 0) { const u32x2 sv = *(const LAS u32x2*)(lds + st_addr(row, ch8));
                v0 += bf_lo(sv.x) * wb; v1 += bf_hi(sv.x) * wb; v2 += bf_lo(sv.y) * wb; v3 += bf_hi(sv.y) * wb; }
            u32x2 w; w.x = pk2(v0, v1); w.y = pk2(v2, v3);
            if (STAGE != 2) *(LAS u32x2*)(lds + st_addr(row, ch8)) = w;
            else *(u32x2*)((unsigned char*)MIX + (size_t)b * SEQ * D * 2 + (unsigned)((tq * D + 512 + h * 64 + 4 * hh) * 2) + (32 * db + 8 * rq) * 2) = w;
        }
    if (STAGE != 2 && hh == 0) ml[row] = (f32x2){mrun, lrun};
}

__device__ __forceinline__ void att_sync() { asm volatile("s_waitcnt lgkmcnt(0)" ::: "memory"); __builtin_amdgcn_s_barrier(); asm volatile("" ::: "memory"); }
__device__ __forceinline__ void attn_unit(const Args& a, Frame& F, int bh, int sb, int nbh, int nsb, BgState& bg, int bg_stride, AttRegs& R) {
    const bf16_t* Q = (const bf16_t*)(a.ws + WS_Q); const bf16_t* K = (const bf16_t*)(a.ws + WS_K); const bf16_t* V = (const bf16_t*)(a.ws + WS_V);
    bf16_t* MIX = (bf16_t*)(a.ws + WS_MIX);
    const int b = bh >> 3, h = bh & 7, T0 = sb * 512;
    const int w2 = 2 * F.wave + __builtin_amdgcn_readfirstlane(*(volatile LAS int*)(F.lds + L_MISC + 32));
    const int t10 = T0 + (w2 >> 2) + 128 * (w2 & 3), t11 = T0 + ((w2 + 1) >> 2) + 128 * ((w2 + 1) & 3);
    wave_tile<0, 16>(a, bg, bg_stride, R, Q, K, V, MIX, b, h, T0, T0 + w2, 16, b, h, T0 + w2 + 1, F.lds, F.wave, F.lane);
    wave_tile<0, 16>(a, bg, bg_stride, R, Q, K, V, MIX, b, h, T0, T0 + w2 + 1, 4, b, h, t10, F.lds, F.wave, F.lane);
    att_sync();
    wave_tile<1, 4>(a, bg, bg_stride, R, Q, K, V, MIX, b, h, T0, t10, 4, b, h, t11, F.lds, F.wave, F.lane);
    wave_tile<1, 4>(a, bg, bg_stride, R, Q, K, V, MIX, b, h, T0, t11, 1, b, h, T0 + 32 * w2, F.lds, F.wave, F.lane);
    att_sync();
    wave_tile<2, 1>(a, bg, bg_stride, R, Q, K, V, MIX, b, h, T0, T0 + 32 * w2, 1, b, h, T0 + 32 * (w2 + 1), F.lds, F.wave, F.lane);
    wave_tile<2, 1>(a, bg, bg_stride, R, Q, K, V, MIX, b, h, T0, T0 + 32 * (w2 + 1), 16, nbh >> 3, nbh & 7, nsb * 512 + w2, F.lds, F.wave, F.lane);
    att_sync();
}
__device__ __forceinline__ void p4_attn(const Args& a, Frame& F) {
    const int lane = F.lane; const int bg_stride = 2 * F.G * 8;
    BgState bg; bg.itA = F.blk * 8 + F.wave; bg.itB = bg.itA + F.G * 8; bg.liveA = 0; bg.liveB = 0;
    bg_issue(a, bg.itA, lane, bg.tmpA); bg.itA += bg_stride; bg_issue(a, bg.itB, lane, bg.tmpB); bg.itB += bg_stride;
    LAS float* bg_scr = (LAS float*)(F.lds + BG_OFF + F.wave * 4224);
    AttRegs R;
#define ATT_UNIT_OF(u_, bh_, sb_) do { const int blk_ = (u_) & 255, i_ = (u_) >> 8, x_ = blk_ & 7, j_ = blk_ >> 3; sb_ = j_ & 15; bh_ = x_ + 8 * ((j_ >> 4) + 2 * i_); } while (0)
    if ((int)F.blk < 512) { int bh0, sb0; ATT_UNIT_OF((int)F.blk, bh0, sb0);
        att_next_v(R, (const bf16_t*)(a.ws + WS_V), 16, bh0 >> 3, bh0 & 7, sb0 * 512 + 2 * F.wave, lane); att_next_qk(R, (const bf16_t*)(a.ws + WS_Q), (const bf16_t*)(a.ws + WS_K), 16, bh0 >> 3, bh0 & 7, sb0 * 512 + 2 * F.wave, lane); }
#pragma unroll 1
    for (int u = F.blk; u < 512; u += F.G) {
        int bh, sb, nbh, nsb; ATT_UNIT_OF(u, bh, sb);
        const int un = (u + (int)F.G < 512) ? u + (int)F.G : u;
        ATT_UNIT_OF(un, nbh, nsb);
        attn_unit(a, F, bh, sb, nbh, nsb, bg, bg_stride, R);
    }
#undef ATT_UNIT_OF
#pragma unroll 1
    while (bg.itA - bg_stride < BG_ITEMS || bg.itB - bg_stride < BG_ITEMS) { BG_STEP(A); BG_STEP(B); }
}
}

__device__ __forceinline__ void p6_norm2_router_valu(const Args& a, Frame& F) {
    constexpr int WP = 1028;
    LAS float* wrT = (LAS float*)F.lds;
    LAS int* rec_e = (LAS int*)(F.lds + 32 * WP * 4);
    LAS int* rec_r = rec_e + 512;
    LAS float* rec_g = (LAS float*)(rec_r + 512);
    LAS int* lcount = (LAS int*)(rec_g + 512);
    LAS int* lbase = lcount + 32;
    const float* mod = (const float*)(a.ws + WS_MOD);
    unsigned char* H2 = a.ws + WS_H;
    gu32* gcnt = (gu32*)(a.ws + WS_CTL) + CW_GCNT;
    int* toklist = (int*)(a.ws + WS_TOKLIST);
    int* tokinfo = (int*)(a.ws + WS_TOKINFO);
    for (int i = F.tid; i < 1024 * 32; i += 512) { const int k = i >> 5, e = i & 31; wrT[e * WP + k] = a.w_router[i]; }
    for (int chunk = F.blk; chunk < T / 128; chunk += F.G) {
        if (F.tid < 32) lcount[F.tid] = 0;
        __syncthreads();
        const int tok0 = chunk * 128, b = tok0 / SEQ;
        f32x4 ga[4], sh[4];
#pragma unroll
        for (int j = 0; j < 4; ++j) { const int col = 4 * F.lane + 256 * j;
            const f32x4 g = *(const f32x4*)(a.g_ffn + col), sc = *(const f32x4*)(mod + b * 6144 + 4096 + col);
            ga[j] = g * (sc + 1.0f); sh[j] = *(const f32x4*)(mod + b * 6144 + 3072 + col); }
        const float brl = a.b_router[F.lane & 31];
#pragma unroll 1
        for (int tt = 0; tt < 16; ++tt) {
            const int tl = F.wave * 16 + tt, m = tok0 + tl;
            const f32x4* xr = (const f32x4*)(a.out + (size_t)m * D) + F.lane;
            f32x4 v[4]; float s = 0.f;
#pragma unroll
            for (int j = 0; j < 4; ++j) { v[j] = xr[64 * j]; s += (v[j].x * v[j].x + v[j].y * v[j].y) + (v[j].z * v[j].z + v[j].w * v[j].w); }
            const float rstd = 1.0f / sqrtf(wave_sum(s) * (1.0f / D) + NORM_EPS);
            unsigned* o4 = (unsigned*)(H2 + (size_t)m * D) + F.lane;
#pragma unroll
            for (int j = 0; j < 4; ++j) { v[j] = (v[j] * rstd) * ga[j] + sh[j]; o4[64 * j] = pk4_fp8(16.0f * v[j].x, 16.0f * v[j].y, 16.0f * v[j].z, 16.0f * v[j].w); }
            float mylogit = -3.0e38f;
#pragma unroll 4
            for (int e = 0; e < 32; ++e) { float p = 0.f;
#pragma unroll
                for (int j = 0; j < 4; ++j) { const f32x4 w = *(const LAS f32x4*)(wrT + e * WP + 4 * F.lane + 256 * j); p += (v[j].x * w.x + v[j].y * w.y) + (v[j].z * w.z + v[j].w * w.w); }
                p = wave_sum(p);
                if (F.lane == e) mylogit = p; }
            if (F.lane < 32) mylogit += brl;
            float tv0, tv1, tv2, tv3; int te0, te1, te2, te3;
#define TOPK_STEP(TV, TE) do { const float mx_ = wave_max(mylogit); const unsigned long long bal_ = __ballot(mylogit == mx_); const int sel_ = __ffsll((long long)bal_) - 1; \
                TV = mx_; TE = sel_; if (F.lane == sel_) mylogit = -3.0e38f; } while (0)
            TOPK_STEP(tv0, te0); TOPK_STEP(tv1, te1); TOPK_STEP(tv2, te2); TOPK_STEP(tv3, te3);
#undef TOPK_STEP
            const float e1 = __expf(tv1 - tv0), e2 = __expf(tv2 - tv0), e3 = __expf(tv3 - tv0); const float inv = 1.0f / (1.0f + e1 + e2 + e3);
            if (F.lane < 4) { int ee = te0; float gg = inv;
                if (F.lane == 1) { ee = te1; gg = e1 * inv; } if (F.lane == 2) { ee = te2; gg = e2 * inv; } if (F.lane == 3) { ee = te3; gg = e3 * inv; }
                const int lr = atomicAdd((int*)&lcount[ee], 1);
                rec_e[tl * 4 + F.lane] = ee; rec_r[tl * 4 + F.lane] = lr; rec_g[tl * 4 + F.lane] = gg; }
        }
        __syncthreads();
        if (F.tid < 32) lbase[F.tid] = (int)__hip_atomic_fetch_add(gcnt + 64 * F.tid, (unsigned)lcount[F.tid], __ATOMIC_RELAXED, __HIP_MEMORY_SCOPE_AGENT);
        __syncthreads();
        { const int tl = F.tid >> 2, k = F.tid & 3, e = rec_e[F.tid], rank = lbase[e] + rec_r[F.tid];
          toklist[(size_t)e * T + rank] = tok0 + tl;
          tokinfo[(size_t)(tok0 + tl) * 8 + 2 * k] = (e << 16) | rank; tokinfo[(size_t)(tok0 + tl) * 8 + 2 * k + 1] = __builtin_bit_cast(int, rec_g[F.tid]); }
        __syncthreads();
    }
}


template <bool DUMP> __device__ __forceinline__ void p6_norm2_router(const Args& a, Frame& F) {
    constexpr int HP = 1028;
    LAS float* ht = (LAS float*)F.lds;
    LAS int* rec_e = (LAS int*)(F.lds + 32 * HP * 4);
    LAS int* rec_r = rec_e + 512;
    LAS float* rec_g = (LAS float*)(rec_r + 512);
    LAS int* lcount = (LAS int*)(rec_g + 512);
    LAS int* lbase = lcount + 32;
    const float* mod = (const float*)(a.ws + WS_MOD);
    unsigned char* H2 = a.ws + (DUMP ? WS_ACT : WS_H);
    gu32* gcnt = (gu32*)(a.ws + WS_CTL) + CW_GCNT + (DUMP ? 4096 : 0);
    int* toklist = (int*)(a.ws + (DUMP ? WS_ACT + 64 * MiB : WS_TOKLIST));
    int* tokinfo = (int*)(a.ws + (DUMP ? WS_ACT + 80 * MiB : WS_TOKINFO));
    const int n = F.lane & 31, hk = F.lane >> 5;
    bf16x8 bhi[8], blo[8];
#pragma unroll
    for (int st = 0; st < 8; ++st) { const int k0 = 128 * F.wave + 16 * st + 8 * hk; u32x4 h4, l4;
#pragma unroll
        for (int jp = 0; jp < 4; ++jp) { const float w0 = a.w_router[(size_t)(k0 + 2 * jp) * 32 + n], w1 = a.w_router[(size_t)(k0 + 2 * jp + 1) * 32 + n];
            const unsigned hp = cvt_pk_bf16(w0, w1); h4[jp] = hp; l4[jp] = cvt_pk_bf16(w0 - bf_lo(hp), w1 - bf_hi(hp)); }
        bhi[st] = __builtin_bit_cast(bf16x8, h4); blo[st] = __builtin_bit_cast(bf16x8, l4); }
    const float brl = a.b_router[n];
    for (int chunk = F.blk; chunk < T / 128; chunk += F.G) {
        if (F.tid < 32) lcount[F.tid] = 0;
        const int tok0 = chunk * 128, b = tok0 / SEQ;
        f32x4 ga[4], sh[4];
#pragma unroll
        for (int j = 0; j < 4; ++j) { const int col = 4 * F.lane + 256 * j;
            const f32x4 g = *(const f32x4*)(a.g_ffn + col), sc = *(const f32x4*)(mod + b * 6144 + 4096 + col);
            ga[j] = g * (sc + 1.0f); sh[j] = *(const f32x4*)(mod + b * 6144 + 3072 + col); }
        f32x4 xv[4][4];
#define P6_LOAD(Q) do { _Pragma("unroll") for (int i = 0; i < 4; ++i) { const u32x2* xr = (const u32x2*)((const bf16_t*)(a.ws + WS_X1B) + (size_t)(tok0 + 32 * (Q) + 4 * F.wave + i) * D) + F.lane; \
            _Pragma("unroll") for (int j = 0; j < 4; ++j) { const u32x2 w_ = xr[64 * j]; xv[i][j] = (f32x4){bf_lo(w_.x), bf_hi(w_.x), bf_lo(w_.y), bf_hi(w_.y)}; } } } while (0)
        P6_LOAD(0);
#pragma unroll 1
        for (int q = 0; q < 4; ++q) {
#pragma unroll
            for (int i = 0; i < 4; ++i) { const int tl = 4 * F.wave + i, m = tok0 + 32 * q + tl;
                f32x4 v[4]; float s = 0.f;
#pragma unroll
                for (int j = 0; j < 4; ++j) { v[j] = xv[i][j]; s += (v[j].x * v[j].x + v[j].y * v[j].y) + (v[j].z * v[j].z + v[j].w * v[j].w); }
                const float rstd = 1.0f / sqrtf(wave_sum(s) * (1.0f / D) + NORM_EPS);
                unsigned* o4 = (unsigned*)(H2 + (size_t)m * D) + F.lane;
#pragma unroll
                for (int j = 0; j < 4; ++j) { v[j] = (v[j] * rstd) * ga[j] + sh[j]; o4[64 * j] = pk4_fp8(16.0f * v[j].x, 16.0f * v[j].y, 16.0f * v[j].z, 16.0f * v[j].w);
                    *(LAS f32x4*)(ht + tl * HP + 4 * F.lane + 256 * j) = v[j]; } }
            if (q < 3) P6_LOAD(q + 1);
            __syncthreads();
            f32x16 acc;
#pragma unroll
            for (int r = 0; r < 16; ++r) acc[r] = 0.f;
#pragma unroll
            for (int st = 0; st < 8; ++st) { const LAS float* ap = ht + n * HP + 128 * F.wave + 16 * st + 8 * hk;
                const f32x4 x0 = *(const LAS f32x4*)ap, x1 = *(const LAS f32x4*)(ap + 4);
                u32x4 h4, l4;
                h4.x = cvt_pk_bf16(x0.x, x0.y); h4.y = cvt_pk_bf16(x0.z, x0.w); h4.z = cvt_pk_bf16(x1.x, x1.y); h4.w = cvt_pk_bf16(x1.z, x1.w);
                l4.x = cvt_pk_bf16(x0.x - bf_lo(h4.x), x0.y - bf_hi(h4.x)); l4.y = cvt_pk_bf16(x0.z - bf_lo(h4.y), x0.w - bf_hi(h4.y));
                l4.z = cvt_pk_bf16(x1.x - bf_lo(h4.z), x1.y - bf_hi(h4.z)); l4.w = cvt_pk_bf16(x1.z - bf_lo(h4.w), x1.w - bf_hi(h4.w));
                const bf16x8 ahi = __builtin_bit_cast(bf16x8, h4), alo = __builtin_bit_cast(bf16x8, l4);
                acc = __builtin_amdgcn_mfma_f32_32x32x16_bf16(ahi, bhi[st], acc, 0, 0, 0);
                acc = __builtin_amdgcn_mfma_f32_32x32x16_bf16(alo, bhi[st], acc, 0, 0, 0);
                acc = __builtin_amdgcn_mfma_f32_32x32x16_bf16(ahi, blo[st], acc, 0, 0, 0); }
            __syncthreads();
#pragma unroll
            for (int r = 0; r < 16; ++r) { const int tk = (r & 3) + 8 * (r >> 2) + 4 * hk; ht[F.wave * 1024 + tk * 32 + n] = acc[r]; }
            __syncthreads();
            { LAS float* L = ht + 8192;
#pragma unroll
              for (int rep = 0; rep < 2; ++rep) { const int o = F.tid + 512 * rep; float sacc = brl;
#pragma unroll
                  for (int w = 0; w < 8; ++w) sacc += ht[w * 1024 + o];
                  L[(o >> 5) * 33 + (o & 31)] = sacc; }
              __syncthreads();
              if (F.wave == 0 && F.lane < 32) { const int tl = 32 * q + F.lane;
                  float lv[32];
#pragma unroll
                  for (int e = 0; e < 32; ++e) lv[e] = L[F.lane * 33 + e];
                  float tv[4]; int te[4];
#pragma unroll
                  for (int k = 0; k < 4; ++k) { float best = lv[0]; int bi = 0;
#pragma unroll
                      for (int e = 1; e < 32; ++e) { const bool gt = lv[e] > best; best = gt ? lv[e] : best; bi = gt ? e : bi; }
                      tv[k] = best; te[k] = bi;
#pragma unroll
                      for (int e = 0; e < 32; ++e) lv[e] = (e == bi) ? -3.0e38f : lv[e]; }
                  const float e1 = __expf(tv[1] - tv[0]), e2 = __expf(tv[2] - tv[0]), e3 = __expf(tv[3] - tv[0]); const float inv = 1.0f / (1.0f + e1 + e2 + e3);
                  const float gk[4] = {inv, e1 * inv, e2 * inv, e3 * inv};
#pragma unroll
                  for (int k = 0; k < 4; ++k) { const int lr = atomicAdd((int*)&lcount[te[k]], 1); rec_e[tl * 4 + k] = te[k]; rec_r[tl * 4 + k] = lr; rec_g[tl * 4 + k] = gk[k]; } } }
            __syncthreads();
        }
#undef P6_LOAD
        if (F.tid < 32) lbase[F.tid] = (int)__hip_atomic_fetch_add(gcnt + 64 * F.tid, (unsigned)lcount[F.tid], __ATOMIC_RELAXED, __HIP_MEMORY_SCOPE_AGENT);
        __syncthreads();
        { const int tl = F.tid >> 2, k = F.tid & 3, e = rec_e[F.tid], rank = lbase[e] + rec_r[F.tid];
          toklist[(size_t)e * T + rank] = tok0 + tl;
          tokinfo[(size_t)(tok0 + tl) * 8 + 2 * k] = (e << 16) | rank; tokinfo[(size_t)(tok0 + tl) * 8 + 2 * k + 1] = __builtin_bit_cast(int, rec_g[F.tid]); }
        __syncthreads();
    }
}

__device__ __forceinline__ int moe_tables(const Args& a, Frame& F) {
    LAS int* tile_e = (LAS int*)(F.lds + L_TILE_E); LAS int* tstart = (LAS int*)(F.lds + L_TSTART); LAS int* cnt = (LAS int*)(F.lds + L_CNT);
    const unsigned* gcnt = (const unsigned*)(a.ws + WS_CTL) + CW_GCNT;
    if (F.tid < 64) {
        const int c = F.tid < 32 ? (int)gcnt[64 * F.tid] : 0; const int nt = (c + 255) >> 8;
        int inc = nt;
#pragma unroll
        for (int o = 1; o < 32; o <<= 1) { const int v = __shfl_up(inc, o); if ((F.tid & 63) >= o) inc += v; }
        if (F.tid < 32) { cnt[F.tid] = c; tstart[F.tid] = inc - nt; }
        if (F.tid == 31) tstart[32] = inc;
    }
    __syncthreads();
    const int RT = tstart[32];
    for (int g = F.tid; g < RT; g += 512) { int e = 0; for (int q = 1; q < 32; ++q) e = (g >= tstart[q]) ? q : e; tile_e[g] = e; }
    __syncthreads();
    return RT;
}

template <bool DUMP> __device__ __forceinline__ void p9_combine(const Args& a, Frame& F) {
    if (N_LAUNCH_MODE == 1) (void)moe_tables(a, F);
    const LAS int* tstart = (const LAS int*)(F.lds + L_TSTART);
    const float* mod = (const float*)(a.ws + WS_MOD);
    const unsigned char* Y = a.ws + WS_Y;
    const int* tokinfo = (const int*)(a.ws + WS_TOKINFO);
    const int gw = F.blk * 8 + F.wave, NGW = F.G * 8;
    f32x4 gfv[4];
#pragma unroll
    for (int j = 0; j < 4; ++j) gfv[j] = *(const f32x4*)(a.g_final + 4 * F.lane + 256 * j);
    int inf = (F.lane < 16 && 2 * gw < T) ? tokinfo[(size_t)(2 * gw) * 8 + F.lane] : 0;
#pragma unroll 1
    for (int m = 2 * gw; m < T; m += 2 * NGW) {
        const int b = m / SEQ;
        const int cur = inf;
        { const int mn = m + 2 * NGW; inf = (F.lane < 16 && mn < T) ? tokinfo[(size_t)mn * 8 + F.lane] : 0; }
        f32x4 v[2][4]; unsigned yv[2][4][4]; float gate[2][4];
        f32x4 g2v[4];
#pragma unroll
        for (int j = 0; j < 4; ++j) g2v[j] = *(const f32x4*)(mod + b * 6144 + 5120 + 4 * F.lane + 256 * j);
#pragma unroll
        for (int t = 0; t < 2; ++t) {
            const u32x2* xr = (const u32x2*)((const bf16_t*)(a.ws + WS_X1B) + (size_t)(m + t) * D) + F.lane;
#pragma unroll
            for (int j = 0; j < 4; ++j) { const u32x2 w_ = xr[64 * j]; v[t][j] = (f32x4){bf_lo(w_.x), bf_hi(w_.x), bf_lo(w_.y), bf_hi(w_.y)}; }
#pragma unroll
            for (int k = 0; k < 4; ++k) { const int er = __builtin_amdgcn_readlane(cur, 8 * t + 2 * k); gate[t][k] = __builtin_bit_cast(float, __builtin_amdgcn_readlane(cur, 8 * t + 2 * k + 1)) * 0.0625f;
                const int e = er >> 16, rank = er & 0xffff; const size_t slot = (size_t)tstart[e] * 256 + rank;
                const unsigned* yr = (const unsigned*)(Y + slot * D) + F.lane;
#pragma unroll
                for (int j = 0; j < 4; ++j) yv[t][k][j] = yr[64 * j]; }
        }
#pragma unroll
        for (int t = 0; t < 2; ++t) {
            f32x4 acc[4];
#pragma unroll
            for (int j = 0; j < 4; ++j) acc[j] = (f32x4){0.f, 0.f, 0.f, 0.f};
#pragma unroll
            for (int k = 0; k < 4; ++k)
#pragma unroll
                for (int j = 0; j < 4; ++j) { const unsigned w = yv[t][k][j]; const float g = gate[t][k]; const f32x2 lo = __builtin_amdgcn_cvt_pk_f32_fp8(w, false), hi = __builtin_amdgcn_cvt_pk_f32_fp8(w, true);
                    acc[j].x += g * lo.x; acc[j].y += g * lo.y; acc[j].z += g * hi.x; acc[j].w += g * hi.y; }
            float s = 0.f;
#pragma unroll
            for (int j = 0; j < 4; ++j) { v[t][j] = v[t][j] + g2v[j] * acc[j];
                s += (v[t][j].x * v[t][j].x + v[t][j].y * v[t][j].y) + (v[t][j].z * v[t][j].z + v[t][j].w * v[t][j].w); }
            const float rstd = 1.0f / sqrtf(wave_sum(s) * (1.0f / D) + NORM_EPS);
            f32x4* xo = (f32x4*)((DUMP ? (float*)(a.ws + WS_ACT) : a.out) + (size_t)(m + t) * D) + F.lane;
#pragma unroll
            for (int j = 0; j < 4; ++j) xo[64 * j] = v[t][j] * rstd * gfv[j];
        }
    }
}

typedef const Args __attribute__((address_space(4)))* KArgsPtr;
static_assert(sizeof(Args) % 8 == 0, "Args is copied in 8-byte words");
__device__ __forceinline__ Args reload_args() {
    KArgsPtr p = (KArgsPtr)__builtin_amdgcn_kernarg_segment_ptr(); asm volatile("" : "+s"(p));
    const unsigned long long __attribute__((address_space(4)))* q = (const unsigned long long __attribute__((address_space(4)))*)p;
    union { Args a; unsigned long long w[sizeof(Args) / 8]; } u;
#pragma unroll
    for (int i = 0; i < (int)(sizeof(Args) / 8); ++i) u.w[i] = q[i];
    return u.a;
}
__global__ void __launch_bounds__(512, 2) fwd_kernel(Args args) {
    extern __shared__ __attribute__((aligned(16))) unsigned char lds_raw[];
    Frame F; F.lds = (LAS unsigned char*)lds_raw; F.tid = threadIdx.x; F.lane = F.tid & 63; F.wave = __builtin_amdgcn_readfirstlane(F.tid >> 6); F.G = gridDim.x; F.blk = blockIdx.x;
    volatile LAS unsigned* misc = (volatile LAS unsigned*)(F.lds + L_MISC);
    if (F.tid < 16) misc[F.tid] = 0u;
    __syncthreads();
    const int lo = args.ph_lo, hi = args.ph_hi;
    unsigned* barw = (unsigned*)(args.ws + WS_CTL) + CW_BAR;
    XcdBarrier bar; bar.bar = barw; bar.x = 0; bar.st = misc;
    if (hi - lo > 1) bar = xcd_barrier_post(barw, misc);
#ifndef PH_MASK
#define PH_MASK 0x3ff
#endif
#define IN(k) (((PH_MASK >> (k)) & 1) && lo <= (k) && (k) < hi)
#ifndef DUP_MASK
#define DUP_MASK 0
#endif
#define DUP(k) (((DUP_MASK >> (k)) & 1) ? 2 : 1)
#define SEAM(k) do { if (IN(k) && IN((k) + 1)) xcd_barrier(bar); } while (0)
    unsigned char* ws = args.ws;

    if (IN(0)) { for (int r_ = 0; r_ < DUP(0); ++r_) { if (r_) xcd_barrier(bar); p0_prologue(args, F); } } SEAM(0);
    if (IN(1)) { for (int r_ = 0; r_ < DUP(1); ++r_) { if (r_) xcd_barrier(bar); p1_norm1(args, F); } } SEAM(1);
    if (IN(2)) for (int r_ = 0; r_ < DUP(2); ++r_) {
        if (r_) xcd_barrier(bar);
        pg8::PlainSched S; S.init(T, INC, F.G, F.blk, ws + WS_H, ws + WS_WIN);
#if FUSE_SPLIT
        static_assert(WS_K - WS_Q == WS_V - WS_K, "q | k | v equally spaced");
        pg8::EpiIn E{(bf16_t*)(ws + WS_U), (bf16_t*)(ws + WS_Q), (const float*)(ws + WS_ROPE)};
        pg8::gemm_phase<pg8::EpiIn, pg8::PlainSched, true>(F.lds, S, E);
#else
        pg8::EpiProj E{(bf16_t*)(ws + WS_PROJ)};
        pg8::gemm_phase<pg8::EpiProj, pg8::PlainSched, true>(F.lds, S, E);
#endif
    } SEAM(2);
#if !FUSE_SPLIT
    if (IN(3)) { for (int r_ = 0; r_ < DUP(3); ++r_) { if (r_) xcd_barrier(bar); p3_split(args, F); } } SEAM(3);
#endif
    if (IN(4)) { if (P4_PARTS & 1) p4_conv(args, F); if (P4_PARTS & 2) att::p4_attn(args, F);
#if (DUP_MASK >> 4) & 1
        xcd_barrier(bar); if (DUP4_PARTS & 1) p4_conv(args, F); if (DUP4_PARTS & 2) att::p4_attn(args, F);
#endif
    } SEAM(4);
    const Args args_late = reload_args(); { const Args& args = args_late; unsigned char* const ws = args.ws;
    if (IN(5)) for (int r_ = 0; r_ < DUP(5); ++r_) {
        if (r_) xcd_barrier(bar);
        pg8::PlainSched S; S.init(T, D, F.G, F.blk, ws + WS_MIX, ws + WS_WOUT);
        pg8::EpiOut E{args.x, (bf16_t*)(ws + WS_X1B), (const float*)(ws + WS_MOD)};
        pg8::gemm_phase<pg8::EpiOut, pg8::PlainSched, true>(F.lds, S, E);
    } SEAM(5);
    if (IN(6)) {
#if (DUP_MASK >> 6) & 1
        p6_norm2_router<true>(args, F); xcd_barrier(bar);
#endif
        if (ROUTER_MFMA) p6_norm2_router<false>(args, F); else p6_norm2_router_valu(args, F); } SEAM(6);
    if (IN(7)) for (int r_ = 0; r_ < DUP(7); ++r_) {
        if (r_) xcd_barrier(bar);
        const int RT = moe_tables(args, F);
        pg8::MoeSched<true> S; S.nN = 8; S.nunits = RT * 8; S.G = F.G; S.c = F.blk; S.A = (const char*)(ws + WS_H); S.Bt = (const char*)(ws + WS_WGU); S.estride = (size_t)2048 * 1024;
        S.tile_e = (const LAS int*)(F.lds + L_TILE_E); S.rowtab = (const LAS unsigned*)(F.lds + L_ROWTAB);
        { LAS unsigned* rowtab = (LAS unsigned*)(F.lds + L_ROWTAB); const LAS int* tstart = (const LAS int*)(F.lds + L_TSTART); const LAS int* cnt = (const LAS int*)(F.lds + L_CNT);
          const int* toklist = (const int*)(ws + WS_TOKLIST); pg8::Unit u;
          unsigned vals[9];
#pragma unroll
          for (int j = 0; j < 9; ++j) { const int i = 2 * j + (F.tid >> 8); vals[j] = 0u;
              if (i < 17 && S.next(i, u)) { const int idx = (u.pm - tstart[u.e]) * 256 + (F.tid & 255); if (idx < cnt[u.e]) vals[j] = (unsigned)toklist[(size_t)u.e * T + idx] * 1024u; } }
#pragma unroll
          for (int j = 0; j < 9; ++j) { const int i = 2 * j + (F.tid >> 8); if (i < 17) rowtab[i * 256 + (F.tid & 255)] = vals[j]; }
          __syncthreads(); }
        pg8::EpiSwiglu E{ws + WS_ACT, args.b_gu};
        pg8::gemm_phase<pg8::EpiSwiglu, pg8::MoeSched<true>, true>(F.lds, S, E);
    } SEAM(7);
    if (IN(8)) for (int r_ = 0; r_ < DUP(8); ++r_) {
        if (r_) xcd_barrier(bar);
        const int RT = (N_LAUNCH_MODE == 1) ? moe_tables(args, F) : ((const LAS int*)(F.lds + L_TSTART))[32];
        pg8::MoeSched<false> S; S.nN = 4; S.nunits = RT * 4; S.G = F.G; S.c = F.blk; S.A = (const char*)(ws + WS_ACT); S.Bt = (const char*)(ws + WS_WDOWN); S.estride = (size_t)1024 * 1024;
        S.tile_e = (const LAS int*)(F.lds + L_TILE_E); S.rowtab = nullptr;
        pg8::EpiDown E{ws + WS_Y, args.b_down};
        pg8::gemm_phase<pg8::EpiDown, pg8::MoeSched<false>, true>(F.lds, S, E);
    } SEAM(8);
    if (IN(9)) {
#if (DUP_MASK >> 9) & 1
        p9_combine<true>(args, F); xcd_barrier(bar);
#endif
        p9_combine<false>(args, F); }
    }
#undef IN
#undef SEAM
}

extern "C" void kernel_launch(void* const* d_in, const int* in_sizes, int n_in, void* d_out, int out_size, void* d_ws, size_t ws_size, hipStream_t stream) {
    static int grid = 0;
    if (grid == 0) {
        if (n_in != 20 || in_sizes[0] != T * D || out_size != T * D || ws_size < WS_END) { fprintf(stderr, "kernel_launch: unexpected shapes (n_in %d, in0 %d, out %d, ws %zu)\n", n_in, n_in > 0 ? in_sizes[0] : -1, out_size, ws_size); grid = -1; return; }
        int dev = 0, cus = 0, per_cu = 0;
        if (hipGetDevice(&dev) != hipSuccess || hipDeviceGetAttribute(&cus, hipDeviceAttributeMultiprocessorCount, dev) != hipSuccess) { grid = -1; return; }
        if (hipFuncSetAttribute((const void*)fwd_kernel, hipFuncAttributeMaxDynamicSharedMemorySize, LDS_BYTES) != hipSuccess) { fprintf(stderr, "kernel_launch: hipFuncSetAttribute failed\n"); grid = -1; return; }
        if (hipOccupancyMaxActiveBlocksPerMultiprocessor(&per_cu, (const void*)fwd_kernel, 512, LDS_BYTES) != hipSuccess || per_cu < 1) { fprintf(stderr, "kernel_launch: occupancy query says %d\n", per_cu); }
        (void)hipGetLastError();
        grid = cus;
    }
    if (grid < 0) return;
    (void)hipMemsetAsync((char*)d_ws + WS_CTL + (size_t)CW_BAR * 4, 0, (size_t)(CW_GCNT + 64 * 32 - CW_BAR) * 4, stream);
    Args a{};
    a.x = (const float*)d_in[0]; a.c = (const float*)d_in[1]; a.pos = (const int*)d_in[2]; a.w_ada = (const float*)d_in[3]; a.b_ada = (const float*)d_in[4]; a.g_mix = (const float*)d_in[5];
    a.w_in = (const float*)d_in[6]; a.conv_w = (const float*)d_in[7]; a.conv_b = (const float*)d_in[8]; a.ln_g = (const float*)d_in[9]; a.ln_b = (const float*)d_in[10]; a.w_out = (const float*)d_in[11];
    a.g_ffn = (const float*)d_in[12]; a.w_router = (const float*)d_in[13]; a.b_router = (const float*)d_in[14]; a.w_gu = (const float*)d_in[15]; a.b_gu = (const float*)d_in[16];
    a.w_down = (const float*)d_in[17]; a.b_down = (const float*)d_in[18]; a.g_final = (const float*)d_in[19];
    a.out = (float*)d_out; a.ws = (unsigned char*)d_ws;
#if N_LAUNCH_MODE == 1
    for (int p = 0; p < NPHASE; ++p) { a.ph_lo = p; a.ph_hi = p + 1; hipLaunchKernelGGL(fwd_kernel, dim3(grid), dim3(512), LDS_BYTES, stream, a); }
#else
    a.ph_lo = 0; a.ph_hi = NPHASE; hipLaunchKernelGGL(fwd_kernel, dim3(grid), dim3(512), LDS_BYTES, stream, a);
#endif
}
```
